# Optimizing an MI355X kernel written in HIP

```python
import math
import jax, jax.numpy as jnp
from jax import lax
import numpy as np

D_MODEL = 2048
BATCH = 8
SEQ = 2048
DEPTH = 4

N_MIXERS = 3
POOL_WINDOWS = (2, 4, 8, 16)
POOL_GROUPS = len(POOL_WINDOWS)
POOL_GROUP = D_MODEL // POOL_GROUPS
N_HEADS = 16
HEAD_DIM = D_MODEL // N_HEADS
Q_BLOCK = 128
D_RNN = D_MODEL
RNN_HEADS = 16
RNN_BLOCK = D_RNN // RNN_HEADS
CONV_WIDTH = 4
LRU_C = 8.0
D_FF = 5632
FFN_CONV_WIDTH = 3
LN_EPS = 1e-5
ALPHA = (2.0 * DEPTH) ** 0.25
BETA = (8.0 * DEPTH) ** -0.25
N_POOL_LAYERS = (DEPTH + 2) // 3
N_ATTN_LAYERS = (DEPTH + 1) // 3
N_REC_LAYERS = DEPTH // 3

kernel_name = "hybrid_pool_fox_rglru_convffn_deepnorm"


def layer_norm(x, g, b):
    xf = x.astype(jnp.float32)
    mu = jnp.mean(xf, axis=-1, keepdims=True)
    var = jnp.mean(jnp.square(xf - mu), axis=-1, keepdims=True)
    y = (xf - mu) * lax.rsqrt(var + LN_EPS)
    return (y * g.astype(jnp.float32) + b.astype(jnp.float32)).astype(x.dtype)


def causal_depthwise_conv(x, w, b):
    K = w.shape[0]
    S = x.shape[1]
    xp = jnp.pad(x, ((0, 0), (K - 1, 0), (0, 0)))
    out = b
    for k in range(K):
        out = out + xp[:, k:k + S] * w[k]
    return out


def pool_mixer(x, w, scale):
    B, S, _ = x.shape
    cs = jnp.cumsum(x.astype(jnp.float32), axis=1)
    pos = jnp.arange(1, S + 1, dtype=jnp.float32)[:, None]
    groups = []
    for g, win in enumerate(POOL_WINDOWS):
        sl = slice(g * POOL_GROUP, (g + 1) * POOL_GROUP)
        c = cs[..., sl]
        lag = jnp.pad(c, ((0, 0), (win, 0), (0, 0)))[:, :S]
        mean = (c - lag) / jnp.minimum(pos, float(win))
        groups.append(mean - x[..., sl].astype(jnp.float32))
    d = jnp.stack(groups, axis=2).astype(x.dtype)
    y = jnp.einsum('bsgc,gcd->bsgd', d, w).reshape(B, S, D_MODEL)
    return y * scale


def fox_attention(x, w_in, b_f, w_o):
    B, S, _ = x.shape
    proj = x @ w_in
    def heads(t):
        return t.reshape(B, S, N_HEADS, HEAD_DIM).transpose(0, 2, 1, 3)
    q = heads(proj[..., :D_MODEL])
    k = heads(proj[..., D_MODEL:2 * D_MODEL])
    v = heads(proj[..., 2 * D_MODEL:3 * D_MODEL])
    log_f = jax.nn.log_sigmoid((proj[..., 3 * D_MODEL:] + b_f).astype(jnp.float32))
    c = jnp.cumsum(log_f, axis=1).transpose(0, 2, 1)
    scale = HEAD_DIM ** -0.5
    outs = []
    for blk in range(S // Q_BLOCK):
        q0 = blk * Q_BLOCK
        q1 = q0 + Q_BLOCK
        qb = q[:, :, q0:q1]
        kb = k[:, :, :q1]
        vb = v[:, :, :q1]
        s = jnp.einsum('bhqd,bhkd->bhqk', qb, kb).astype(jnp.float32) * scale
        s = s + c[:, :, q0:q1, None] - c[:, :, None, :q1]
        mask = jnp.arange(q0, q1)[:, None] >= jnp.arange(q1)[None, :]
        s = jnp.where(mask, s, -jnp.inf)
        p = jax.nn.softmax(s, axis=-1).astype(v.dtype)
        outs.append(jnp.einsum('bhqk,bhkd->bhqd', p, vb))
    o = jnp.concatenate(outs, axis=2).transpose(0, 2, 1, 3).reshape(B, S, D_MODEL)
    return o @ w_o


def rglru_block(x, w_in, conv_w, conv_b, w_a, b_a, w_i, b_i, lam, w_o):
    B, S, _ = x.shape
    u = x @ w_in
    xb = u[..., :D_RNN]
    gate = jax.nn.gelu(u[..., D_RNN:], approximate=True)
    xb = causal_depthwise_conv(xb, conv_w, conv_b)
    xh = xb.reshape(B, S, RNN_HEADS, RNN_BLOCK)
    r_gate = jax.nn.sigmoid(jnp.einsum('bshc,hcd->bshd', xh, w_a).reshape(B, S, D_RNN) + b_a)
    i_gate = jax.nn.sigmoid(jnp.einsum('bshc,hcd->bshd', xh, w_i).reshape(B, S, D_RNN) + b_i)
    log_a = -LRU_C * r_gate.astype(jnp.float32) * jax.nn.softplus(-lam.astype(jnp.float32))
    a = jnp.exp(log_a)
    mult = jnp.sqrt(-jnp.expm1(2.0 * log_a))
    mult = mult.at[:, 0].set(1.0)
    bterm = mult * (i_gate * xb).astype(jnp.float32)

    def combine(left, right):
        a1, b1 = left
        a2, b2 = right
        return a1 * a2, a2 * b1 + b2

    _, h = lax.associative_scan(combine, (a, bterm), axis=1)
    y = h.astype(x.dtype) * gate
    return y @ w_o


def conv_ffn(x, w_up, conv_w, conv_b, w_down):
    h = causal_depthwise_conv(x @ w_up, conv_w, conv_b)
    g = h[..., :D_FF]
    v = h[..., D_FF:]
    return (jax.nn.silu(g) * v) @ w_down


def setup_inputs(seed: int = 0) -> dict:
    key = jax.random.key(seed)
    ks = jax.random.split(key, 24)

    def nrm(k, shape, s):
        return jax.random.normal(k, shape, jnp.float32) * s

    D = D_MODEL
    x = nrm(ks[0], (BATCH, SEQ, D), 1.0)
    pool_w = nrm(ks[1], (N_POOL_LAYERS, POOL_GROUPS, POOL_GROUP, POOL_GROUP), BETA * POOL_GROUP ** -0.5)
    pool_scale = 1.0 + nrm(ks[2], (N_POOL_LAYERS, D), 0.1)
    w_qk = nrm(ks[3], (N_ATTN_LAYERS, D, 2 * D), D ** -0.5)
    w_v = nrm(ks[4], (N_ATTN_LAYERS, D, D), BETA * D ** -0.5)
    w_f = nrm(ks[5], (N_ATTN_LAYERS, D, N_HEADS), D ** -0.5)
    attn_w_in = jnp.concatenate([w_qk, w_v, w_f], axis=-1)
    attn_b_f = 2.0 + nrm(ks[6], (N_ATTN_LAYERS, N_HEADS), 0.5)
    attn_w_o = nrm(ks[7], (N_ATTN_LAYERS, D, D), BETA * D ** -0.5)
    rec_w_in = nrm(ks[8], (N_REC_LAYERS, D, 2 * D_RNN), D ** -0.5)
    rec_conv_w = nrm(ks[9], (N_REC_LAYERS, CONV_WIDTH, D_RNN), CONV_WIDTH ** -0.5)
    rec_conv_b = nrm(ks[10], (N_REC_LAYERS, D_RNN), 0.01)
    rec_w_a = nrm(ks[11], (N_REC_LAYERS, RNN_HEADS, RNN_BLOCK, RNN_BLOCK), RNN_BLOCK ** -0.5)
    rec_b_a = nrm(ks[12], (N_REC_LAYERS, D_RNN), 0.01)
    rec_w_i = nrm(ks[13], (N_REC_LAYERS, RNN_HEADS, RNN_BLOCK, RNN_BLOCK), RNN_BLOCK ** -0.5)
    rec_b_i = nrm(ks[14], (N_REC_LAYERS, D_RNN), 0.01)
    a_c = jax.random.uniform(ks[15], (N_REC_LAYERS, D_RNN), jnp.float32, 0.9, 0.999)
    sig = a_c ** (1.0 / LRU_C)
    rec_lam = jnp.log(sig) - jnp.log1p(-sig)
    rec_w_o = nrm(ks[16], (N_REC_LAYERS, D_RNN, D), BETA * D_RNN ** -0.5)
    ln_g = 1.0 + nrm(ks[17], (DEPTH, 2, D), 0.05)
    ln_b = nrm(ks[18], (DEPTH, 2, D), 0.02)
    ffn_w_up = nrm(ks[19], (DEPTH, D, 2 * D_FF), D ** -0.5)
    ffn_conv_w = nrm(ks[20], (DEPTH, FFN_CONV_WIDTH, 2 * D_FF), FFN_CONV_WIDTH ** -0.5)
    ffn_conv_b = nrm(ks[21], (DEPTH, 2 * D_FF), 0.01)
    ffn_w_down = nrm(ks[22], (DEPTH, D_FF, D), BETA * D_FF ** -0.5)
    return {"x": x, "pool_w": pool_w, "pool_scale": pool_scale,
            "attn_w_in": attn_w_in, "attn_b_f": attn_b_f, "attn_w_o": attn_w_o,
            "rec_w_in": rec_w_in, "rec_conv_w": rec_conv_w, "rec_conv_b": rec_conv_b,
            "rec_w_a": rec_w_a, "rec_b_a": rec_b_a, "rec_w_i": rec_w_i, "rec_b_i": rec_b_i,
            "rec_lam": rec_lam, "rec_w_o": rec_w_o, "ln_g": ln_g, "ln_b": ln_b,
            "ffn_w_up": ffn_w_up, "ffn_conv_w": ffn_conv_w, "ffn_conv_b": ffn_conv_b,
            "ffn_w_down": ffn_w_down}


def reference(x, pool_w, pool_scale, attn_w_in, attn_b_f, attn_w_o, rec_w_in, rec_conv_w, rec_conv_b,
              rec_w_a, rec_b_a, rec_w_i, rec_b_i, rec_lam, rec_w_o, ln_g, ln_b,
              ffn_w_up, ffn_conv_w, ffn_conv_b, ffn_w_down):
    for layer in range(DEPTH):
        kind = layer % N_MIXERS
        j = layer // N_MIXERS
        if kind == 0:
            m = pool_mixer(x, pool_w[j], pool_scale[j])
        elif kind == 1:
            m = fox_attention(x, attn_w_in[j], attn_b_f[j], attn_w_o[j])
        else:
            m = rglru_block(x, rec_w_in[j], rec_conv_w[j], rec_conv_b[j], rec_w_a[j], rec_b_a[j],
                            rec_w_i[j], rec_b_i[j], rec_lam[j], rec_w_o[j])
        x = layer_norm(ALPHA * x + m, ln_g[layer, 0], ln_b[layer, 0])
        f = conv_ffn(x, ffn_w_up[layer], ffn_conv_w[layer], ffn_conv_b[layer], ffn_w_down[layer])
        x = layer_norm(ALPHA * x + f, ln_g[layer, 1], ln_b[layer, 1])
    return x
```

```cpp
#include <hip/hip_runtime.h>
#include <hip/hip_bf16.h>
#include <hip/hip_cooperative_groups.h>
#include <cstdio>
#include <cstdint>
namespace cg = cooperative_groups;

#ifndef MK_MULTI
#define MK_MULTI 0
#endif

#define LAS __attribute__((address_space(3)))
typedef unsigned short bf16_t;
typedef short bf16x8 __attribute__((ext_vector_type(8)));
typedef short s16x4 __attribute__((ext_vector_type(4)));
typedef float f32x2 __attribute__((ext_vector_type(2)));
typedef float f32x4 __attribute__((ext_vector_type(4)));
typedef float f32x16 __attribute__((ext_vector_type(16)));
typedef unsigned u32x2 __attribute__((ext_vector_type(2)));
typedef unsigned u32x4 __attribute__((ext_vector_type(4)));

constexpr int NB = 8, SEQ = 2048, DM = 2048, T = NB * SEQ, FF = 5632, FF2 = 2 * FF, NH = 16;
constexpr float LN_EPS = 1e-5f;
constexpr float ALPHA = 1.681792830507429f;
constexpr int NQKV = 6400;

constexpr size_t MiB = 1ull << 20;
constexpr size_t WS_WUP = 0, WUP_L = (size_t)FF2 * DM * 2;
constexpr size_t WS_WDN = 176 * MiB, WDN_L = (size_t)DM * FF * 2;
constexpr size_t WS_WPOOL = 264 * MiB;
constexpr size_t WS_WAIN = 268 * MiB;
constexpr size_t WS_WAO = 293 * MiB;
constexpr size_t WS_WRIN = 301 * MiB;
constexpr size_t WS_WRG = 317 * MiB;
constexpr size_t WS_WRO = 319 * MiB;
constexpr size_t WS_XB = 327 * MiB;
constexpr size_t WS_XBF = 455 * MiB;
constexpr size_t WS_H = 519 * MiB;
constexpr size_t WS_ACT = 871 * MiB;
constexpr size_t WS_FG = 1047 * MiB;
constexpr size_t WS_CP = 1048 * MiB;
constexpr size_t WS_CH = 1050 * MiB;
constexpr size_t WS_SP = 1052 * MiB;
constexpr size_t WS_BAR = 1053 * MiB;
constexpr size_t WS_ST = 1054 * MiB;
constexpr size_t WS_END = 1055 * MiB;
constexpr size_t TD2 = (size_t)T * DM * 2;

constexpr int LDS_BYTES = 131072 + 16384 + 64;

__device__ __forceinline__ int my_tid() { int t = threadIdx.x; asm volatile("" : "+v"(t)); return t; }
__device__ __forceinline__ int my_bid() { int b = blockIdx.x; asm volatile("" : "+s"(b)); return b; }
__device__ __forceinline__ int my_grid() { int g = gridDim.x; asm volatile("" : "+s"(g)); return g; }
__device__ __forceinline__ unsigned cvt_pk_bf16(float lo, float hi) { unsigned r; asm volatile("v_cvt_pk_bf16_f32 %0, %1, %2" : "=v"(r) : "v"(lo), "v"(hi)); return r; }
__device__ __forceinline__ float bf_lo(unsigned u) { return __uint_as_float(u << 16); }
__device__ __forceinline__ float bf_hi(unsigned u) { return __uint_as_float(u & 0xffff0000u); }

namespace pg8 {
constexpr int BM = 256, BK = 64, HALF = 128, HTB = HALF * BK * 2, STAGE_BYTES = 8 * HTB, NXCD = 8, WGM = 8;
__device__ __forceinline__ int lds_byte(int r, int c) { const int st = (r >> 4) * 2 + (c >> 5), rr = r & 15, cc = c & 31, ob = rr * 64 + cc * 2; return st * 1024 + (ob ^ (((ob >> 9) & 1) << 5)); }
__device__ __forceinline__ void stage_rc(int b, int& R, int& C) { const int st = b / 1024, sb = b % 1024, swz = sb ^ (((sb >> 9) & 1) << 5); R = (st >> 1) * 16 + swz / 64; C = (st & 1) * 32 + (swz % 64) / 2; }
__device__ __forceinline__ int perm32(int rho) { const int n = rho >> 4, i = rho & 15; return 8 * (i >> 2) + 4 * n + (i & 3); }

struct Unit { int pm, pn; };
struct Gemm { const bf16_t* A; const bf16_t* Bt; int K, lda, ldb, tpg, a_gs; };

struct StaticOrder {
    int nM, nN, nwg, G, c;
    __device__ void init(int M, int N, int G_, int c_) { nM = M / BM; nN = N / BM; nwg = nM * nN; G = G_; c = c_; }
    __device__ bool next(int i, Unit& u) const {
        const long L = (long)i * G + c; if (L >= nwg) return false;
        int wgid = (int)L; { const int q = nwg / NXCD, r = nwg % NXCD, xcd = wgid % NXCD, off = wgid / NXCD; wgid = (xcd < r ? xcd * (q + 1) : r * (q + 1) + (xcd - r) * q) + off; }
        const int nig = WGM * nN, gid = wgid / nig, fm = gid * WGM, gsz = (nM - fm) < WGM ? (nM - fm) : WGM;
        u.pm = fm + ((wgid % nig) % gsz); u.pn = (wgid % nig) / gsz; return true;
    }
};

template <class Epi>
__device__ __forceinline__ void gemm_phase(LAS unsigned char* lds, const Gemm g, const StaticOrder& S, const Epi& E) {
    const int tid = my_tid(), wid = __builtin_amdgcn_readfirstlane(tid >> 6), lane = tid & 63, wr = wid >> 2, wc = wid & 3, fr = lane & 15, fq = lane >> 4;
    int K = g.K, lda_ = g.lda, ldb_ = g.ldb; asm volatile("" : "+s"(K), "+s"(lda_), "+s"(ldb_));
    const int nt = K / BK;
    unsigned voffA[2], voffB[2];
#pragma unroll
    for (int i = 0; i < 2; ++i) { int R, C; stage_rc(tid * 16 + i * 8192, R, C); const int Rb = Epi::PERM ? ((R & ~31) + perm32(R & 31)) : R;
        voffA[i] = (unsigned)(R * lda_ + C) * 2u; voffB[i] = (unsigned)(Rb * ldb_ + C) * 2u; }
    const size_t kstep = (size_t)(BK * 2);
    const size_t hstepA = (size_t)HALF * lda_ * 2, hstepB = (size_t)HALF * ldb_ * 2;
    const unsigned ldsw = (unsigned)wid * 1024u;
    const int aoff = lds_byte(wr * 64 + fr, fq * 8), boff = lds_byte(wc * 32 + fr, fq * 8);
#define PG8_SA(b, h) (((b) * 2 + (h)) * HTB)
#define PG8_SB(b, h) ((4 + (b) * 2 + (h)) * HTB)
#define PG8_STAGE(bufoff, gbase, voff) do { _Pragma("unroll") for (int _i = 0; _i < 2; ++_i) \
        __builtin_amdgcn_global_load_lds((const unsigned*)((const char*)(gbase) + (voff)[_i]), (LAS unsigned*)(lds + (bufoff) + ldsw + _i * 8192), 16, 0, 0); } while (0)
#define PG8_LDA(dst, b, h) do { _Pragma("unroll") for (int m = 0; m < 4; ++m) _Pragma("unroll") for (int k = 0; k < 2; ++k) dst[m][k] = *(const LAS bf16x8*)(lds + PG8_SA(b, h) + aoff + m * 2048 + k * 1024); } while (0)
#define PG8_LDB(dst, b, h) do { _Pragma("unroll") for (int n = 0; n < 2; ++n) _Pragma("unroll") for (int k = 0; k < 2; ++k) dst[n][k] = *(const LAS bf16x8*)(lds + PG8_SB(b, h) + boff + n * 2048 + k * 1024); } while (0)
#define PG8_MMA(ai, bj, At, Bt) do { __builtin_amdgcn_s_setprio(1); _Pragma("unroll") for (int m = 0; m < 4; ++m) _Pragma("unroll") for (int n = 0; n < 2; ++n) _Pragma("unroll") for (int k = 0; k < 2; ++k) \
        acc[ai][bj][m][n] = __builtin_amdgcn_mfma_f32_16x16x32_bf16(Bt[n][k], At[m][k], acc[ai][bj][m][n], 0, 0, 0); __builtin_amdgcn_s_setprio(0); } while (0)
#define PG8_WAIT_V(n) asm volatile("s_waitcnt vmcnt(" #n ")" ::: "memory")
#define PG8_WAIT_L(n) asm volatile("s_waitcnt lgkmcnt(" #n ")" ::: "memory")
#define PG8_BAR __builtin_amdgcn_s_barrier()
#define PG8_SCHED __builtin_amdgcn_sched_barrier(0)
#define PG8_ABASE(u) ((const char*)g.A + ((size_t)((u).pn / g.tpg) * g.a_gs) * 2 + (size_t)(u).pm * 2 * hstepA)
#define PG8_BBASE(u) ((const char*)g.Bt + (size_t)(u).pn * 2 * hstepB)
    Unit cur, nxt; int ui = 0;
    if (!S.next(0, cur)) return;
    f32x4 acc[2][2][4][2];
#pragma unroll
    for (int a = 0; a < 2; ++a)
#pragma unroll
        for (int b = 0; b < 2; ++b)
#pragma unroll
            for (int m = 0; m < 4; ++m)
#pragma unroll
                for (int n = 0; n < 2; ++n) acc[a][b][m][n] = (f32x4){0.f, 0.f, 0.f, 0.f};
    bf16x8 At[4][2], B0[2][2], B1[2][2];
    const char* cA = PG8_ABASE(cur); const char* cB = PG8_BBASE(cur);
    PG8_STAGE(PG8_SB(0, 0), cB, voffB); PG8_STAGE(PG8_SA(0, 0), cA, voffA); PG8_STAGE(PG8_SB(0, 1), cB + hstepB, voffB); PG8_STAGE(PG8_SA(0, 1), cA + hstepA, voffA);
    if (wr == 1) PG8_BAR;
    PG8_WAIT_V(4); PG8_BAR;
    PG8_STAGE(PG8_SB(1, 0), cB + kstep, voffB); PG8_STAGE(PG8_SA(1, 0), cA + kstep, voffA); PG8_STAGE(PG8_SB(1, 1), cB + hstepB + kstep, voffB);
    PG8_WAIT_V(6); PG8_BAR;
    for (;;) {
        const bool has_next = S.next(ui + 1, nxt);
        const char* nA = has_next ? PG8_ABASE(nxt) : cA; const char* nB = has_next ? PG8_BBASE(nxt) : cB;
        for (int t = 0; t < nt; t += 2) {
            const bool last = (t == nt - 2);
            const char* a1 = cA + (size_t)(t + 1) * kstep;
            const char* a2 = last ? nA : cA + (size_t)(t + 2) * kstep; const char* b2 = last ? nB : cB + (size_t)(t + 2) * kstep;
            const char* a3 = a2 + kstep; const char* b3 = b2 + kstep;
            PG8_LDB(B0, 0, 0); PG8_SCHED; PG8_LDA(At, 0, 0); PG8_STAGE(PG8_SA(1, 1), a1 + hstepA, voffA);
            PG8_WAIT_L(8); PG8_BAR; PG8_WAIT_L(0); PG8_MMA(0, 0, At, B0); PG8_BAR; PG8_SCHED;
            PG8_LDB(B1, 0, 1); PG8_STAGE(PG8_SB(0, 0), b2, voffB);
            PG8_BAR; PG8_WAIT_L(0); PG8_MMA(0, 1, At, B1); PG8_BAR;
            PG8_LDA(At, 0, 1); PG8_STAGE(PG8_SA(0, 0), a2, voffA);
            PG8_BAR; PG8_WAIT_L(0); PG8_MMA(1, 0, At, B0); PG8_BAR; PG8_SCHED;
            PG8_STAGE(PG8_SB(0, 1), b2 + hstepB, voffB);
            PG8_WAIT_V(6); PG8_BAR; PG8_MMA(1, 1, At, B1); PG8_BAR;
            PG8_LDB(B0, 1, 0); PG8_SCHED; PG8_LDA(At, 1, 0); PG8_STAGE(PG8_SA(0, 1), a2 + hstepA, voffA);
            PG8_WAIT_L(8); PG8_BAR; PG8_WAIT_L(0); PG8_MMA(0, 0, At, B0); PG8_BAR; PG8_SCHED;
            PG8_LDB(B1, 1, 1); PG8_STAGE(PG8_SB(1, 0), b3, voffB);
            PG8_BAR; PG8_WAIT_L(0); PG8_MMA(0, 1, At, B1); PG8_BAR;
            PG8_LDA(At, 1, 1); PG8_STAGE(PG8_SA(1, 0), a3, voffA);
            PG8_BAR; PG8_WAIT_L(0); PG8_MMA(1, 0, At, B0); PG8_BAR; PG8_SCHED;
            PG8_STAGE(PG8_SB(1, 1), b3 + hstepB, voffB);
            PG8_WAIT_V(6); PG8_BAR; PG8_MMA(1, 1, At, B1); PG8_BAR;
        }
        E(acc, cur, wr, wc, fr, fq);
        if (!has_next) break;
#pragma unroll
        for (int a = 0; a < 2; ++a)
#pragma unroll
            for (int b = 0; b < 2; ++b)
#pragma unroll
                for (int m = 0; m < 4; ++m)
#pragma unroll
                    for (int n = 0; n < 2; ++n) acc[a][b][m][n] = (f32x4){0.f, 0.f, 0.f, 0.f};
        cur = nxt; cA = nA; cB = nB; ++ui;
    }
    PG8_WAIT_V(0);
    if (wr == 0) PG8_BAR;
    PG8_BAR;
#undef PG8_SA
#undef PG8_SB
#undef PG8_STAGE
#undef PG8_LDA
#undef PG8_LDB
#undef PG8_MMA
#undef PG8_WAIT_V
#undef PG8_WAIT_L
#undef PG8_BAR
#undef PG8_SCHED
#undef PG8_ABASE
#undef PG8_BBASE
}


struct EpiRes {
    static constexpr bool PERM = true;
    const float* R; float* Y; const float* cs; const float* pst; const float* pg; const float* pb;
    __device__ __forceinline__ void operator()(const f32x4 (&acc)[2][2][4][2], const Unit& u, int wr, int wc, int fr, int fq) const {
        asm volatile("" : "+v"(fr), "+v"(fq));
        const int urow = u.pm * BM + wr * 64, ucol = u.pn * BM + wc * 32;
        const unsigned l4 = (unsigned)(fr * DM + 8 * fq) * 4u, ls = (unsigned)fr * 8u, lc = (unsigned)fq * 32u;
        f32x4 ra0[2], ra1[2], rb0[2], rb1[2]; f32x2 sa[2], sb[2];
        f32x4 g0 = {1.f, 1.f, 1.f, 1.f}, g1 = g0, b0 = {0.f, 0.f, 0.f, 0.f}, b1 = b0, c0 = g0, c1v = g0;
#define ER_LOAD(r0, r1, sv, ai, bj, mh) do { _Pragma("unroll") for (int mm = 0; mm < 2; ++mm) { const int m = 2 * (mh) + mm; const size_t uo = (size_t)(urow + (ai) * HALF + m * 16) * DM + ucol + (bj) * HALF; \
            const char* rp = (const char*)(R + uo) + l4; r0[mm] = *(const f32x4*)rp; r1[mm] = *(const f32x4*)(rp + 16); \
            sv[mm] = pst ? *(const f32x2*)((const char*)(pst + (size_t)(urow + (ai) * HALF + m * 16) * 2) + ls) : (f32x2){0.f, 1.f}; } } while (0)
#define ER_COLS(bj) do { const int cu = ucol + (bj) * HALF; \
            if (pst) { const char* gp = (const char*)(pg + cu) + lc; const char* bp = (const char*)(pb + cu) + lc; \
                g0 = *(const f32x4*)gp; g1 = *(const f32x4*)(gp + 16); b0 = *(const f32x4*)bp; b1 = *(const f32x4*)(bp + 16); } \
            if (cs) { const char* cp = (const char*)(cs + cu) + lc; c0 = *(const f32x4*)cp; c1v = *(const f32x4*)(cp + 16); } } while (0)
#define ER_PROC(r0, r1, sv, ai, bj, mh) do { const int cu = ucol + (bj) * HALF; \
            _Pragma("unroll") for (int mm = 0; mm < 2; ++mm) { const int m = 2 * (mh) + mm; const size_t uo = (size_t)(urow + (ai) * HALF + m * 16) * DM + cu; \
                f32x4 q0 = r0[mm], q1 = r1[mm]; \
                if (pst) { q0 = (q0 - sv[mm].x) * sv[mm].y * g0 + b0; q1 = (q1 - sv[mm].x) * sv[mm].y * g1 + b1; } \
                char* yp = (char*)(Y + uo) + l4; \
                *(f32x4*)yp = q0 * ALPHA + acc[ai][bj][m][0] * c0; *(f32x4*)(yp + 16) = q1 * ALPHA + acc[ai][bj][m][1] * c1v; } } while (0)
        ER_COLS(0);
        ER_LOAD(ra0, ra1, sa, 0, 0, 0); asm volatile("" ::: "memory");
        ER_LOAD(rb0, rb1, sb, 0, 0, 1); asm volatile("" ::: "memory");
        ER_PROC(ra0, ra1, sa, 0, 0, 0); asm volatile("" ::: "memory");
        ER_LOAD(ra0, ra1, sa, 1, 0, 0); asm volatile("" ::: "memory");
        ER_PROC(rb0, rb1, sb, 0, 0, 1); asm volatile("" ::: "memory");
        ER_LOAD(rb0, rb1, sb, 1, 0, 1); asm volatile("" ::: "memory");
        ER_PROC(ra0, ra1, sa, 1, 0, 0); asm volatile("" ::: "memory");
        ER_LOAD(ra0, ra1, sa, 0, 1, 0); asm volatile("" ::: "memory");
        ER_PROC(rb0, rb1, sb, 1, 0, 1); asm volatile("" ::: "memory");
        ER_COLS(1); asm volatile("" ::: "memory");
        ER_LOAD(rb0, rb1, sb, 0, 1, 1); asm volatile("" ::: "memory");
        ER_PROC(ra0, ra1, sa, 0, 1, 0); asm volatile("" ::: "memory");
        ER_LOAD(ra0, ra1, sa, 1, 1, 0); asm volatile("" ::: "memory");
        ER_PROC(rb0, rb1, sb, 0, 1, 1); asm volatile("" ::: "memory");
        ER_LOAD(rb0, rb1, sb, 1, 1, 1); asm volatile("" ::: "memory");
        ER_PROC(ra0, ra1, sa, 1, 1, 0); asm volatile("" ::: "memory");
        ER_PROC(rb0, rb1, sb, 1, 1, 1); asm volatile("" ::: "memory");
#undef ER_LOAD
#undef ER_COLS
#undef ER_PROC
    }
};

__device__ __forceinline__ float gelu_tanh(float x) {
    const float u = 0.7978845608028654f * (x + 0.044715f * x * x * x);
    const float e = __expf(2.f * u);
    const float th = 1.f - 2.f * __builtin_amdgcn_rcpf(1.f + e);
    return 0.5f * x * (1.f + th);
}

struct EpiGen {
    static constexpr bool PERM = true;
    bf16_t* O; int ldc; int mode; float* FG;
    __device__ __forceinline__ void operator()(const f32x4 (&acc)[2][2][4][2], const Unit& u, int wr, int wc, int fr, int fq) const {
        asm volatile("" : "+v"(fr), "+v"(fq));
        const int row0 = u.pm * BM + wr * 64 + fr; const int pn = u.pn;
        bf16_t* base = O; int ld = ldc; int colt = pn * BM; bool act = false;
        if (mode == 1) {
            if (pn == 24) {
                if (wc == 0 && fq < 2) {
#pragma unroll
                    for (int ai = 0; ai < 2; ++ai)
#pragma unroll
                        for (int m = 0; m < 4; ++m) { float* p = FG + (size_t)(row0 + ai * HALF + m * 16) * 16 + 8 * fq;
                            *(f32x4*)p = acc[ai][0][m][0]; *(f32x4*)(p + 4) = acc[ai][0][m][1]; }
                }
                return;
            }
            base = O + (size_t)(pn >> 3) * ((size_t)T * DM); colt = (pn & 7) * BM;
        } else if (mode == 2) {
            base = O + (size_t)(pn >> 3) * ((size_t)T * DM); colt = (pn & 7) * BM; act = (pn >= 8);
        }
        const int col0 = colt + wc * 32 + 8 * fq;
#pragma unroll
        for (int ai = 0; ai < 2; ++ai)
#pragma unroll
            for (int m = 0; m < 4; ++m) { bf16_t* rowp = base + (size_t)(row0 + ai * HALF + m * 16) * ld + col0;
#pragma unroll
                for (int bj = 0; bj < 2; ++bj) { f32x4 v0 = acc[ai][bj][m][0], v1 = acc[ai][bj][m][1];
                    if (act) {
#pragma unroll
                        for (int j = 0; j < 4; ++j) { v0[j] = gelu_tanh(v0[j]); v1[j] = gelu_tanh(v1[j]); } }
                    u32x4 w; w.x = cvt_pk_bf16(v0[0], v0[1]); w.y = cvt_pk_bf16(v0[2], v0[3]); w.z = cvt_pk_bf16(v1[0], v1[1]); w.w = cvt_pk_bf16(v1[2], v1[3]);
                    *(u32x4*)(rowp + bj * HALF) = w; } }
    }
};

struct EpiGates {
    static constexpr bool PERM = false;
    const float* b_a; const float* b_i; const float* SP; const bf16_t* XBC; bf16_t* LA; bf16_t* BTb;
    __device__ __forceinline__ void operator()(const f32x4 (&acc)[2][2][4][2], const Unit& u, int wr, int wc, int fr, int fq) const {
        asm volatile("" : "+v"(fr), "+v"(fq));
        const int row0 = u.pm * BM + wr * 64 + fr, ch0 = u.pn * 128 + wc * 32 + 4 * fq;
#pragma unroll
        for (int n = 0; n < 2; ++n) {
            const f32x4 ba = *(const f32x4*)(b_a + ch0 + 16 * n), bi = *(const f32x4*)(b_i + ch0 + 16 * n), sp = *(const f32x4*)(SP + ch0 + 16 * n);
#pragma unroll
            for (int ai = 0; ai < 2; ++ai)
#pragma unroll
                for (int m = 0; m < 4; ++m) { const int t = row0 + ai * HALF + m * 16; const bool first = (t & (SEQ - 1)) == 0;
                    const size_t off = (size_t)t * DM + ch0 + 16 * n;
                    const u32x2 xw = *(const u32x2*)(XBC + off); const float xb[4] = {bf_lo(xw.x), bf_hi(xw.x), bf_lo(xw.y), bf_hi(xw.y)};
                    f32x4 av, bv;
#pragma unroll
                    for (int j = 0; j < 4; ++j) {
                        const float r = __builtin_amdgcn_rcpf(1.f + __expf(-(acc[ai][0][m][n][j] + ba[j])));
                        const float ig = __builtin_amdgcn_rcpf(1.f + __expf(-(acc[ai][1][m][n][j] + bi[j])));
                        const float la = -8.f * r * sp[j];
                        const float a = __expf(la);
                        const float z = 2.f * la;
                        const float ser = -z * (1.f + 0.5f * z * (1.f + (1.f / 3.f) * z * (1.f + 0.25f * z)));
                        const float em = (z > -0.1f) ? ser : (1.f - a * a);
                        const float mult = first ? 1.f : sqrtf(em);
                        av[j] = la; bv[j] = mult * ig * xb[j]; }
                    u32x2 wa, wb; wa.x = cvt_pk_bf16(av[0], av[1]); wa.y = cvt_pk_bf16(av[2], av[3]); wb.x = cvt_pk_bf16(bv[0], bv[1]); wb.y = cvt_pk_bf16(bv[2], bv[3]);
                    *(u32x2*)(LA + off) = wa; *(u32x2*)(BTb + off) = wb;
                    asm volatile("" ::: "memory"); }
        }
    }
};
}

namespace att {
constexpr int D = 128, RS = DM, W = SEQ;
constexpr float SCALE = 0.08838834764831845f, THR = 24.f;
constexpr int NW = 8, QBLK = 32, KVBLK = 64, QB = NW * QBLK;
constexpr int SHM_V = KVBLK * D * 2, SHM_K = KVBLK * D * 2;
constexpr int ATT_LDS = 2 * SHM_V + 2 * SHM_K + NW * 64 * 4;
using bf16 = bf16_t;
#define KSWZ(row, colB) ((row) * 256 + ((colB) ^ (((row) & 7) << 4)))
#define SBAR() __builtin_amdgcn_sched_barrier(0)
__device__ __forceinline__ int v_st(int k, int c) { const int kk = (k & ~0xC) | ((k & 4) << 1) | ((k & 8) >> 1); return ((kk >> 3) * 4 + (c >> 5)) * 512 + ((kk & 7) * 32 + (c & 31)) * 2; }
__device__ __forceinline__ int v_rd_base(int lane) { return ((lane & 3) << 3) | (((lane >> 2) & 3) << 6) | (((lane >> 4) & 1) << 5) | (((lane >> 5) & 1) << 8); }
constexpr int v_rd_off(int d0, int ks, int half) { return d0 * 512 + ks * 4096 + half * 2048; }
__device__ __forceinline__ int crow(int r, int hi) { return (r & 3) + 8 * (r >> 2) + 4 * hi; }
__device__ __forceinline__ bf16x8 load8(const bf16* p) { return *reinterpret_cast<const bf16x8*>(p); }
__device__ __forceinline__ void mask_tile(f32x16& p0, f32x16& p1, int dq, unsigned Wm) {
    const float NEG = -__builtin_inff();
#pragma unroll
    for (int r = 0; r < 16; ++r) {
        const int c = (r & 3) + 8 * (r >> 2);
        if ((unsigned)(dq - c) >= Wm) p0[r] = NEG;
        if ((unsigned)(dq - c - 32) >= Wm) p1[r] = NEG;
    }
}
__device__ __forceinline__ void partialSM(f32x16& p0, f32x16& p1, float& m_reg, float& mn, float& alpha) {
    float pmax = p0[0];
#pragma unroll
    for (int r = 1; r < 16; ++r) pmax = fmaxf(pmax, p0[r]);
#pragma unroll
    for (int r = 0; r < 16; ++r) pmax = fmaxf(pmax, p1[r]);
    { auto rr = __builtin_amdgcn_permlane32_swap(__float_as_uint(pmax), __float_as_uint(pmax), false, false);
      pmax = fmaxf(__uint_as_float(rr[0]), __uint_as_float(rr[1])); }
    constexpr float C2 = 1.4426950408889634f * SCALE;
    if (__builtin_expect(__all((pmax - m_reg) * SCALE <= THR), 1)) { mn = m_reg; alpha = 1.f; }
    else { mn = fmaxf(m_reg, pmax); alpha = __builtin_amdgcn_exp2f((m_reg - mn) * C2); m_reg = mn; }
    const float mnL = -mn * C2;
#pragma unroll
    for (int r = 0; r < 16; ++r) p0[r] = fmaf(p0[r], C2, mnL);
#pragma unroll
    for (int r = 0; r < 16; ++r) p1[r] = fmaf(p1[r], C2, mnL);
#pragma unroll
    for (int r = 0; r < 16; ++r) p0[r] = __builtin_amdgcn_exp2f(p0[r]);
}
__device__ __forceinline__ void finishSM(f32x16& p0, f32x16& p1, float alpha, float& l_reg, bf16x8& pa0, bf16x8& pa1, bf16x8& pa2, bf16x8& pa3) {
#pragma unroll
    for (int r = 0; r < 16; ++r) p1[r] = __builtin_amdgcn_exp2f(p1[r]);
    float ps = 0;
#pragma unroll
    for (int r = 0; r < 16; ++r) ps += p0[r];
#pragma unroll
    for (int r = 0; r < 16; ++r) ps += p1[r];
    { auto rr = __builtin_amdgcn_permlane32_swap(__float_as_uint(ps), __float_as_uint(ps), false, false);
      ps = __uint_as_float(rr[0]) + __uint_as_float(rr[1]); }
    l_reg = l_reg * alpha + ps;
#define PK4(P, B_, OUT) do { unsigned a0 = cvt_pk_bf16(P[B_+0], P[B_+1]), a1 = cvt_pk_bf16(P[B_+2], P[B_+3]);                          \
        unsigned b0 = cvt_pk_bf16(P[B_+4], P[B_+5]), b1 = cvt_pk_bf16(P[B_+6], P[B_+7]);                                             \
        auto r0 = __builtin_amdgcn_permlane32_swap(a0, b0, false, false); auto r1 = __builtin_amdgcn_permlane32_swap(a1, b1, false, false); \
        u32x4 w = {r0[0], r1[0], r0[1], r1[1]}; OUT = *reinterpret_cast<bf16x8*>(&w); } while (0)
    PK4(p0, 0, pa0); PK4(p0, 8, pa1); PK4(p1, 0, pa2); PK4(p1, 8, pa3);
#undef PK4
}
template <int KB>
__device__ __forceinline__ void qkt(f32x16& p0, f32x16& p1, const char* K_lds, int r32, int hi, const bf16x8* qr, const float* bt) {
#pragma unroll
    for (int g = 0; g < 4; ++g) { const f32x4 x0 = *(const f32x4*)(bt + 8 * g), x1 = *(const f32x4*)(bt + 32 + 8 * g);
#pragma unroll
        for (int j = 0; j < 4; ++j) { p0[4 * g + j] = x0[j]; p1[4 * g + j] = x1[j]; } }
    const char* kb[4];
#pragma unroll
    for (int dd = 0; dd < 4; ++dd) kb[dd] = K_lds + KB * SHM_K + KSWZ(r32, (dd * 16 + hi * 8) * 2);
#pragma unroll
    for (int d0 = 0; d0 < 8; ++d0) { const char* a = kb[d0 & 3] + (d0 >> 2) * 128;
        bf16x8 b0 = *reinterpret_cast<const bf16x8*>(a);
        bf16x8 b1 = *reinterpret_cast<const bf16x8*>(a + 32 * 256);
        p0 = __builtin_amdgcn_mfma_f32_32x32x16_bf16(b0, qr[d0], p0, 0, 0, 0);
        p1 = __builtin_amdgcn_mfma_f32_32x32x16_bf16(b1, qr[d0], p1, 0, 0, 0); }
}
template <int VB>
__device__ __forceinline__ void pv_tile(f32x16* o, int vb0, bf16x8 pa0, bf16x8 pa1, bf16x8 pa2, bf16x8 pa3) {
#define TRRD(dst, off) asm volatile("ds_read_b64_tr_b16 %0, %1 offset:%2" : "=&v"(dst) : "v"(vb0), "i"(off) : "memory")
#define PV_D0(d0) do { s16x4 l0, l1, l2, l3, h0, h1, h2, h3; constexpr int b_ = VB * SHM_V + v_rd_off(d0, 0, 0); \
        TRRD(l0, b_); TRRD(h0, b_ + 2048); TRRD(l1, b_ + 4096); TRRD(h1, b_ + 6144); TRRD(l2, b_ + 8192); TRRD(h2, b_ + 10240); TRRD(l3, b_ + 12288); TRRD(h3, b_ + 14336); \
        asm volatile("s_waitcnt lgkmcnt(0)" ::: "memory"); SBAR();   \
        o[d0] = __builtin_amdgcn_mfma_f32_32x32x16_bf16(pa0, (bf16x8){l0[0], l0[1], l0[2], l0[3], h0[0], h0[1], h0[2], h0[3]}, o[d0], 0, 0, 0);   \
        o[d0] = __builtin_amdgcn_mfma_f32_32x32x16_bf16(pa1, (bf16x8){l1[0], l1[1], l1[2], l1[3], h1[0], h1[1], h1[2], h1[3]}, o[d0], 0, 0, 0);   \
        o[d0] = __builtin_amdgcn_mfma_f32_32x32x16_bf16(pa2, (bf16x8){l2[0], l2[1], l2[2], l2[3], h2[0], h2[1], h2[2], h2[3]}, o[d0], 0, 0, 0);   \
        o[d0] = __builtin_amdgcn_mfma_f32_32x32x16_bf16(pa3, (bf16x8){l3[0], l3[1], l3[2], l3[3], h3[0], h3[1], h3[2], h3[3]}, o[d0], 0, 0, 0); } while (0)
    PV_D0(0); PV_D0(1); PV_D0(2); PV_D0(3);
#undef PV_D0
#undef TRRD
}

__device__ __forceinline__ int opaque_hi(int hi) { asm volatile("" : "+v"(hi)); return hi; }
struct BlockRef { const bf16* Q; const bf16* K; const bf16* V; bf16* O; int P0; };
struct Seam { bf16x8 qr[8]; bf16x8 st_v0, st_v1, st_k0, st_k1; };
#define ROW(p, k0, rr) ((p) + (size_t)((k0) + (rr)) * RS + sc)
#define VMW() asm volatile("s_waitcnt vmcnt(0)" ::: "memory")
#define VMWN(n) asm volatile("s_waitcnt vmcnt(%0)" :: "i"(n) : "memory")
#define SLOAD_H(Kp, Vp, k0) do { S.st_v0 = load8(ROW(Vp, k0, sr)); S.st_v1 = load8(ROW(Vp, k0, 32 + sr));              \
                         S.st_k0 = load8(ROW(Kp, k0, sr)); S.st_k1 = load8(ROW(Kp, k0, 32 + sr)); } while (0)
#define SWRITE_HK(bf) do { *(bf16x8*)(K_lds + (bf) * SHM_K + kws) = S.st_k0; *(bf16x8*)(K_lds + (bf) * SHM_K + kws + 32 * 256) = S.st_k1; } while (0)
#define SWRITE_HV(bf) do { *(bf16x8*)(V_lds + (bf) * SHM_V + vst0) = S.st_v0; *(bf16x8*)(V_lds + (bf) * SHM_V + vst0 + 8192) = S.st_v1; } while (0)
#define SWRITE_H(bf) do { SWRITE_HV(bf); SWRITE_HK(bf); } while (0)

__device__ __forceinline__ void prime(const BlockRef& cur, char* lds, Seam& S) {
    const int tid = my_tid(), wid = __builtin_amdgcn_readfirstlane(tid >> 6), lane = tid & 63, r32 = lane & 31, hi = lane >> 5;
    const int sr = tid >> 4, sc = (tid & 15) * 8, kws = KSWZ(sr, sc * 2); char* K_lds = lds + 2 * SHM_V;
#pragma unroll
    for (int d0 = 0; d0 < 8; ++d0) S.qr[d0] = load8(cur.Q + (size_t)(wid * QBLK + r32) * RS + d0 * 16 + hi * 8);
    SLOAD_H(cur.K, cur.V, 0); VMW(); SWRITE_HK(0);
    __syncthreads();
}
__device__ __forceinline__ void block(const BlockRef& cur, const BlockRef& nxt, char* lds, Seam& S, const float* bias_l) {
    const int tid = my_tid(), wid = __builtin_amdgcn_readfirstlane(tid >> 6), lane = tid & 63, r32 = lane & 31, hi = lane >> 5;
    const int NT = (cur.P0 + QB - 1) / KVBLK + 1;
    const int qlo = cur.P0 + wid * QBLK, qm = qlo + r32 - 4 * hi;
    char* V_lds = lds; char* K_lds = lds + 2 * SHM_V;
    float* ws = (float*)(lds + 2 * SHM_V + 2 * SHM_K) + wid * 64; float* li_l = ws, * al_l = ws + 32;
    float m_reg = -1e30f, l_reg = 0; f32x16 o[4] = {};
    const int sr = tid >> 4, sc = (tid & 15) * 8, vst0 = v_st(sr, sc), kws = KSWZ(sr, sc * 2);
    const int vb0 = (int)(uintptr_t)V_lds + v_rd_base(lane);
    const bf16* Kh = cur.K; const bf16* Vh = cur.V;
#define RESC(a) do { if (__any((a) < 1.f)) { if (hi == 0) al_l[r32] = (a); asm volatile("s_waitcnt lgkmcnt(0)" ::: "memory");              \
                     for (int d_ = 0; d_ < 4; ++d_) for (int r = 0; r < 16; ++r) o[d_][r] *= al_l[crow(r, hi)]; } } while (0)
#define KBASE(t) ((t) * KVBLK)
#define BIASP(t) (bias_l + KBASE(t) + 4 * opaque_hi(hi))
#define MASKT(P0_, P1_, t) do { const int kb_ = KBASE(t); if (kb_ + KVBLK - 1 > qlo) mask_tile(P0_, P1_, qm - kb_, (unsigned)W); } while (0)
#define SEAM_K0() do { VMWN(8); SWRITE_HK(0); SBAR(); } while (0)
    f32x16 pA0, pA1, pB0, pB1; float mnA, mnB, alA, alB; bf16x8 pa0, pa1, pa2, pa3;
    SWRITE_HV(0); SBAR();
    if (NT > 1) { SLOAD_H(Kh, Vh, KBASE(1)); }
    SBAR(); qkt<0>(pA0, pA1, K_lds, r32, hi, S.qr, BIASP(0));
    MASKT(pA0, pA1, 0); partialSM(pA0, pA1, m_reg, mnA, alA);
    if (NT > 1) { VMW(); SWRITE_H(1); }
    __syncthreads();
#define HALF_STEP(PX0, PX1, mnX, alX, PY0, PY1, alY, t, KB, VB, SB) do {                                                      \
        SBAR(); qkt<KB>(PX0, PX1, K_lds, r32, hi, S.qr, BIASP(t));                                             \
        finishSM(PY0, PY1, alY, l_reg, pa0, pa1, pa2, pa3); SBAR();                                                           \
        if ((t) + 1 < NT) { SLOAD_H(Kh, Vh, KBASE((t) + 1)); SBAR(); }                                               \
        pv_tile<VB>(o, vb0, pa0, pa1, pa2, pa3); MASKT(PX0, PX1, (t)); partialSM(PX0, PX1, m_reg, mnX, alX);                                        \
        __syncthreads();                                                                                                      \
        if ((t) + 1 < NT) { VMW(); SWRITE_H(SB); }                                                                          \
        RESC(alX); __syncthreads(); } while (0)
    for (int t = 1; t + 1 < NT; t += 2) {
        HALF_STEP(pB0, pB1, mnB, alB, pA0, pA1, alA, t, 1, 0, 0);
        HALF_STEP(pA0, pA1, mnA, alA, pB0, pB1, alB, t + 1, 0, 1, 1);
    }
    const bool even = (NT & 1) == 0;
    if (even) { SBAR(); qkt<1>(pB0, pB1, K_lds, r32, hi, S.qr, BIASP(NT - 1)); SBAR(); }
    SLOAD_H(nxt.K, nxt.V, 0); SBAR();
#pragma unroll
    for (int d0 = 0; d0 < 8; ++d0) S.qr[d0] = load8(nxt.Q + (size_t)(wid * QBLK + r32) * RS + d0 * 16 + hi * 8);
    SBAR();
    finishSM(pA0, pA1, alA, l_reg, pa0, pa1, pa2, pa3); SBAR();
    pv_tile<0>(o, vb0, pa0, pa1, pa2, pa3);
    if (even) { MASKT(pB0, pB1, NT - 1); partialSM(pB0, pB1, m_reg, mnB, alB); __syncthreads(); RESC(alB);
        finishSM(pB0, pB1, alB, l_reg, pa0, pa1, pa2, pa3); SBAR(); pv_tile<1>(o, vb0, pa0, pa1, pa2, pa3); }
    SBAR(); SEAM_K0();
    if (hi == 0) li_l[r32] = l_reg; asm volatile("s_waitcnt lgkmcnt(0)" ::: "memory");
    float rli[16];
#pragma unroll
    for (int r = 0; r < 16; ++r) rli[r] = __builtin_amdgcn_rcpf(li_l[crow(r, hi)]);
    bf16* Ow = cur.O + (size_t)(wid * QBLK) * RS;
#pragma unroll
    for (int r = 0; r < 16; ++r) { const int orow = crow(r, hi);
#pragma unroll
        for (int d0 = 0; d0 < 4; ++d0) { const float v = o[d0][r] * rli[r];
            const float vn = __shfl_xor(v, 1);
            if ((r32 & 1) == 0) *(unsigned*)(Ow + (size_t)orow * RS + d0 * 32 + r32) = cvt_pk_bf16(v, vn); } }
    __syncthreads();
#undef RESC
#undef KBASE
#undef BIASP
#undef MASKT
#undef SEAM_K0
#undef HALF_STEP
}
#undef ROW
#undef VMW
#undef VMWN
#undef SLOAD_H
#undef SWRITE_HK
#undef SWRITE_HV
#undef SWRITE_H

__device__ __forceinline__ void fox_bias(float* bias_l, float* wtot, const float* FG, const float* b_f, int b, int h) {
    const int tid = my_tid(), wid = tid >> 6, lane = tid & 63;
    const float bf = b_f[h];
    float lf[4];
#pragma unroll
    for (int i = 0; i < 4; ++i) { const float z = FG[((size_t)b * SEQ + tid * 4 + i) * 16 + h] + bf; lf[i] = fminf(z, 0.f) - log1pf(__expf(-fabsf(z))); }
    lf[1] += lf[0]; lf[2] += lf[1]; lf[3] += lf[2];
    const float tot = lf[3]; float sc = tot;
#pragma unroll
    for (int off = 1; off < 64; off <<= 1) { const float v = __shfl_up(sc, off); if (lane >= off) sc += v; }
    if (lane == 63) wtot[wid] = sc;
    __syncthreads();
    float basev = 0.f;
    for (int w = 0; w < wid; ++w) basev += wtot[w];
    const float ex = basev + sc - tot;
    const float inv = -1.0f / SCALE;
    f32x4 o4 = {(ex + lf[0]) * inv, (ex + lf[1]) * inv, (ex + lf[2]) * inv, (ex + lf[3]) * inv};
    *(f32x4*)(bias_l + tid * 4) = o4;
    __syncthreads();
}

__device__ __forceinline__ BlockRef mkref(int bh, int qb, const bf16* Q, const bf16* K, const bf16* V, bf16* O) {
    const int b = bh >> 4, h = bh & 15; BlockRef r;
    const size_t kv0 = (size_t)b * SEQ * RS + (size_t)h * D, q0 = kv0 + (size_t)qb * QB * RS;
    r.Q = Q + q0; r.O = O + q0; r.K = K + kv0; r.V = V + kv0; r.P0 = qb * QB; return r;
}
__device__ __forceinline__ void attn_phase(char* lds, const bf16* Q, const bf16* K, const bf16* V, bf16* O, const float* FG, const float* b_f) {
    float* bias_l = (float*)(lds + 131072);
    const int G = my_grid(), total = 512;
    const int bx = my_bid(); const int vid = (G % 8 == 0) ? (bx % 8) * (G / 8) + bx / 8 : bx;
    int L = vid; if (L >= total) return;
    int bh = L >> 2, x = L & 3, pass = 0, slot = 0;
    BlockRef cur = mkref(bh, x, Q, K, V, O);
    fox_bias(bias_l, bias_l + 2 * SEQ, FG, b_f, bh >> 4, bh & 15);
    if (L + G < total) { const int b2 = (L + G) >> 2; fox_bias(bias_l + SEQ, bias_l + 2 * SEQ, FG, b_f, b2 >> 4, b2 & 15); }
    Seam S;
    prime(cur, lds, S);
    for (;;) {
        const bool more_pass = pass == 0, more_item = (L + G < total) && slot == 0, last = !more_pass && !more_item;
        int bhn = bh, xn = x, passn = 1, Ln = L;
        if (!more_pass) { passn = 0; Ln = more_item ? L + G : L; bhn = Ln >> 2; xn = Ln & 3; }
        const BlockRef nxt = last ? cur : mkref(bhn, passn ? 7 - xn : xn, Q, K, V, O);
        block(cur, nxt, lds, S, bias_l + slot * SEQ);
        if (last) break;
        if (!more_pass) slot = 1;
        cur = nxt; bh = bhn; x = xn; pass = passn; L = Ln;
    }
}
}

__device__ __forceinline__ void convT(float* tile, const float* src, int K, int Nsrc, int Ndst, bf16_t* dst, int rot) {
    const int tid = my_tid(), G = my_grid();
    const int ntn = Ndst / 128, ntk = K / 128, ntiles = ntn * ntk;
    for (int ti = (my_bid() + rot) % G; ti < ntiles; ti += G) {
        const int tk = ti / ntn, tn = ti % ntn;
        const int c4 = (tid & 31) * 4, n = tn * 128 + c4;
        f32x4 v[8];
#pragma unroll
        for (int i = 0; i < 8; ++i) { const int k = (tid >> 5) + 16 * i;
            v[i] = (n < Nsrc) ? *(const f32x4*)(src + (size_t)(tk * 128 + k) * Nsrc + n) : (f32x4){0.f, 0.f, 0.f, 0.f}; }
#pragma unroll
        for (int i = 0; i < 8; ++i) { const int k = (tid >> 5) + 16 * i; *(f32x4*)(tile + k * 132 + c4) = v[i]; }
        __syncthreads();
        const int nn = tid & 127, kg0 = tid >> 7;
#pragma unroll
        for (int j = 0; j < 4; ++j) { const int kg = kg0 + 4 * j; const float* tp = tile + (kg * 8) * 132 + nn;
            u32x4 w; w.x = cvt_pk_bf16(tp[0], tp[132]); w.y = cvt_pk_bf16(tp[2 * 132], tp[3 * 132]); w.z = cvt_pk_bf16(tp[4 * 132], tp[5 * 132]); w.w = cvt_pk_bf16(tp[6 * 132], tp[7 * 132]);
            *(u32x4*)(dst + (size_t)(tn * 128 + nn) * K + tk * 128 + kg * 8) = w; }
        __syncthreads();
    }
}
__device__ __forceinline__ void conv_gates(const float* w_a, const float* w_i, bf16_t* dst) {
    const int n = 4096 * 256;
    for (int i = my_bid() * 512 + my_tid(); i < n; i += my_grid() * 512) {
        const int k = i & 255, row = i >> 8, h = row >> 8, gate = (row >> 7) & 1, d = row & 127;
        float v = 0.f;
        if ((k >> 7) == (h & 1)) v = (gate ? w_i : w_a)[((size_t)h * 128 + (k & 127)) * 128 + d];
        dst[i] = (bf16_t)(cvt_pk_bf16(v, 0.f) & 0xffffu);
    }
}

__device__ __forceinline__ void pool_diff(const float* X, bf16_t* DB) {
    const int nitems = NB * 64 * 512;
    for (int item = my_bid() * 512 + my_tid(); item < nitems; item += my_grid() * 512) {
        const int c4 = item & 511, tc = (item >> 9) & 63, b = item >> 15;
        const int win = 2 << (c4 >> 7), t0 = tc * 32;
        const float* xp = X + (size_t)b * SEQ * DM + c4 * 4;
        bf16_t* dp = DB + (size_t)b * SEQ * DM + c4 * 4;
        f32x4 s = {0.f, 0.f, 0.f, 0.f};
        int ts = t0 - win; if (ts < 0) ts = 0;
        for (int t = ts; t < t0; ++t) s += *(const f32x4*)(xp + (size_t)t * DM);
#pragma unroll 8
        for (int t = t0; t < t0 + 32; ++t) {
            const f32x4 v = *(const f32x4*)(xp + (size_t)t * DM);
            f32x4 old = {0.f, 0.f, 0.f, 0.f};
            if (t - win >= 0) old = *(const f32x4*)(xp + (size_t)(t - win) * DM);
            s += v - old;
            const int cnt = (t + 1 < win) ? t + 1 : win;
            const float inv = 1.0f / (float)cnt;
            const f32x4 d = s * inv - v;
            u32x2 w; w.x = cvt_pk_bf16(d[0], d[1]); w.y = cvt_pk_bf16(d[2], d[3]);
            *(u32x2*)(dp + (size_t)t * DM) = w;
        }
    }
}

__device__ __forceinline__ void ln_phase(float* Y, const float* g, const float* bta, bf16_t* XBFp, float* st, bool inplace) {
    const int wid = my_tid() >> 6, lane = my_tid() & 63;
    for (int row = my_bid() * 8 + wid; row < T; row += my_grid() * 8) {
        float* yp = Y + (size_t)row * DM;
        f32x4 v[8];
#pragma unroll
        for (int i = 0; i < 8; ++i) v[i] = *(const f32x4*)(yp + (i * 64 + lane) * 4);
        float s = 0.f;
#pragma unroll
        for (int i = 0; i < 8; ++i) s += (v[i][0] + v[i][1]) + (v[i][2] + v[i][3]);
#pragma unroll
        for (int o = 32; o >= 1; o >>= 1) s += __shfl_xor(s, o);
        const float mean = s * (1.0f / DM);
        float q = 0.f;
#pragma unroll
        for (int i = 0; i < 8; ++i) { const f32x4 d = v[i] - mean; q += (d[0] * d[0] + d[1] * d[1]) + (d[2] * d[2] + d[3] * d[3]); }
#pragma unroll
        for (int o = 32; o >= 1; o >>= 1) q += __shfl_xor(q, o);
        const float rstd = 1.0f / sqrtf(q * (1.0f / DM) + LN_EPS);
        if (lane == 0) *(f32x2*)(st + (size_t)row * 2) = (f32x2){mean, rstd};
#pragma unroll
        for (int i = 0; i < 8; ++i) { const int c = (i * 64 + lane) * 4;
            const f32x4 gg = *(const f32x4*)(g + c), bb = *(const f32x4*)(bta + c);
            const f32x4 y = (v[i] - mean) * rstd * gg + bb;
            if (inplace) *(f32x4*)(yp + c) = y;
            u32x2 w; w.x = cvt_pk_bf16(y[0], y[1]); w.y = cvt_pk_bf16(y[2], y[3]);
            *(u32x2*)(XBFp + (size_t)row * DM + c) = w; }
    }
}

__device__ __forceinline__ void unpack8(const u32x4 w, float* f) {
    f[0] = bf_lo(w.x); f[1] = bf_hi(w.x); f[2] = bf_lo(w.y); f[3] = bf_hi(w.y); f[4] = bf_lo(w.z); f[5] = bf_hi(w.z); f[6] = bf_lo(w.w); f[7] = bf_hi(w.w);
}
__device__ __forceinline__ void convgate_phase(const bf16_t* H, const float* cw, const float* cb, bf16_t* ACT) {
    constexpr int CL = 92, NCH = (SEQ + CL - 1) / CL;
    const int nf8 = FF / 8, nitems = NB * NCH * nf8;
    for (int item = my_bid() * 512 + my_tid(); item < nitems; item += my_grid() * 512) {
        const int f8 = item % nf8, rest = item / nf8, tc = rest % NCH, b = rest / NCH;
        const int f = f8 * 8, t0 = tc * CL, t1 = (t0 + CL < SEQ) ? t0 + CL : SEQ;
        float wg[3][8], wv[3][8], bg[8], bv[8];
#pragma unroll
        for (int k = 0; k < 3; ++k)
#pragma unroll
            for (int h = 0; h < 2; ++h) { const f32x4 a = *(const f32x4*)(cw + (size_t)k * FF2 + f + 4 * h), c = *(const f32x4*)(cw + (size_t)k * FF2 + FF + f + 4 * h);
#pragma unroll
                for (int j = 0; j < 4; ++j) { wg[k][4 * h + j] = a[j]; wv[k][4 * h + j] = c[j]; } }
#pragma unroll
        for (int h = 0; h < 2; ++h) { const f32x4 a = *(const f32x4*)(cb + f + 4 * h), c = *(const f32x4*)(cb + FF + f + 4 * h);
#pragma unroll
            for (int j = 0; j < 4; ++j) { bg[4 * h + j] = a[j]; bv[4 * h + j] = c[j]; } }
        const bf16_t* hp = H + (size_t)b * SEQ * FF2 + f;
        bf16_t* ap = ACT + (size_t)b * SEQ * FF + f;
        float g1[8], g2[8], v1[8], v2[8];
        if (t0 == 0) {
#pragma unroll
            for (int j = 0; j < 8; ++j) { g1[j] = 0.f; g2[j] = 0.f; v1[j] = 0.f; v2[j] = 0.f; }
        } else {
            unpack8(*(const u32x4*)(hp + (size_t)(t0 - 1) * FF2), g1); unpack8(*(const u32x4*)(hp + (size_t)(t0 - 2) * FF2), g2);
            unpack8(*(const u32x4*)(hp + (size_t)(t0 - 1) * FF2 + FF), v1); unpack8(*(const u32x4*)(hp + (size_t)(t0 - 2) * FF2 + FF), v2);
        }
#pragma unroll 4
        for (int t = t0; t < t1; ++t) {
            float g0[8], v0[8];
            unpack8(*(const u32x4*)(hp + (size_t)t * FF2), g0); unpack8(*(const u32x4*)(hp + (size_t)t * FF2 + FF), v0);
            float o[8];
#pragma unroll
            for (int j = 0; j < 8; ++j) {
                const float gg = bg[j] + wg[0][j] * g2[j] + wg[1][j] * g1[j] + wg[2][j] * g0[j];
                const float vv = bv[j] + wv[0][j] * v2[j] + wv[1][j] * v1[j] + wv[2][j] * v0[j];
                o[j] = gg * __builtin_amdgcn_rcpf(1.f + __expf(-gg)) * vv;
                g2[j] = g1[j]; g1[j] = g0[j]; v2[j] = v1[j]; v1[j] = v0[j];
            }
            u32x4 w; w.x = cvt_pk_bf16(o[0], o[1]); w.y = cvt_pk_bf16(o[2], o[3]); w.z = cvt_pk_bf16(o[4], o[5]); w.w = cvt_pk_bf16(o[6], o[7]);
            *(u32x4*)(ap + (size_t)t * FF) = w;
        }
    }
}
__device__ __forceinline__ void conv4_phase(const bf16_t* XBR, const float* cw, const float* cb, bf16_t* XBC) {
    const int nitems = NB * 64 * 256;
    for (int item = my_bid() * 512 + my_tid(); item < nitems; item += my_grid() * 512) {
        const int c8 = item & 255, tc = (item >> 8) & 63, b = item >> 14;
        const int c = c8 * 8, t0 = tc * 32;
        float w[4][8], bb[8];
#pragma unroll
        for (int k = 0; k < 4; ++k)
#pragma unroll
            for (int h = 0; h < 2; ++h) { const f32x4 a = *(const f32x4*)(cw + (size_t)k * DM + c + 4 * h);
#pragma unroll
                for (int j = 0; j < 4; ++j) w[k][4 * h + j] = a[j]; }
#pragma unroll
        for (int h = 0; h < 2; ++h) { const f32x4 a = *(const f32x4*)(cb + c + 4 * h);
#pragma unroll
            for (int j = 0; j < 4; ++j) bb[4 * h + j] = a[j]; }
        const bf16_t* xp = XBR + (size_t)b * SEQ * DM + c;
        bf16_t* op = XBC + (size_t)b * SEQ * DM + c;
        float x1[8], x2[8], x3[8];
        if (t0 == 0) {
#pragma unroll
            for (int j = 0; j < 8; ++j) { x1[j] = 0.f; x2[j] = 0.f; x3[j] = 0.f; }
        } else {
            unpack8(*(const u32x4*)(xp + (size_t)(t0 - 1) * DM), x1); unpack8(*(const u32x4*)(xp + (size_t)(t0 - 2) * DM), x2); unpack8(*(const u32x4*)(xp + (size_t)(t0 - 3) * DM), x3);
        }
#pragma unroll 4
        for (int t = t0; t < t0 + 32; ++t) {
            float x0[8]; unpack8(*(const u32x4*)(xp + (size_t)t * DM), x0);
            float o[8];
#pragma unroll
            for (int j = 0; j < 8; ++j) { o[j] = bb[j] + w[0][j] * x3[j] + w[1][j] * x2[j] + w[2][j] * x1[j] + w[3][j] * x0[j]; x3[j] = x2[j]; x2[j] = x1[j]; x1[j] = x0[j]; }
            u32x4 wv; wv.x = cvt_pk_bf16(o[0], o[1]); wv.y = cvt_pk_bf16(o[2], o[3]); wv.z = cvt_pk_bf16(o[4], o[5]); wv.w = cvt_pk_bf16(o[6], o[7]);
            *(u32x4*)(op + (size_t)t * DM) = wv;
        }
    }
}
__device__ __forceinline__ void scan1_phase(const bf16_t* LA, const bf16_t* BTb, float* CP, float* CH) {
    const int nitems = NB * 32 * 512;
    for (int item = my_bid() * 512 + my_tid(); item < nitems; item += my_grid() * 512) {
        const int c4 = item & 511, ck = (item >> 9) & 31, b = item >> 14;
        const size_t base = ((size_t)b * SEQ + ck * 64) * DM + c4 * 4;
        f32x4 L = {0.f, 0.f, 0.f, 0.f}, Hh = {0.f, 0.f, 0.f, 0.f};
#pragma unroll 8
        for (int t = 0; t < 64; ++t) { const u32x2 lw = *(const u32x2*)(LA + base + (size_t)t * DM), bw = *(const u32x2*)(BTb + base + (size_t)t * DM);
            const f32x4 la = {bf_lo(lw.x), bf_hi(lw.x), bf_lo(lw.y), bf_hi(lw.y)}, bt = {bf_lo(bw.x), bf_hi(bw.x), bf_lo(bw.y), bf_hi(bw.y)};
            f32x4 a; a[0] = __expf(la[0]); a[1] = __expf(la[1]); a[2] = __expf(la[2]); a[3] = __expf(la[3]);
            L += la; Hh = a * Hh + bt; }
        const size_t co = ((size_t)b * 32 + ck) * DM + c4 * 4;
        f32x4 P; P[0] = __expf(L[0]); P[1] = __expf(L[1]); P[2] = __expf(L[2]); P[3] = __expf(L[3]);
        *(f32x4*)(CP + co) = P; *(f32x4*)(CH + co) = Hh;
    }
}
__device__ __forceinline__ void scan2_phase(const bf16_t* LA, const bf16_t* BTb, const float* CP, const float* CH, const bf16_t* GATE, bf16_t* YG) {
    const int nitems = NB * 32 * 512;
    for (int item = my_bid() * 512 + my_tid(); item < nitems; item += my_grid() * 512) {
        const int c4 = item & 511, ck = (item >> 9) & 31, b = item >> 14;
        f32x4 Hh = {0.f, 0.f, 0.f, 0.f};
        for (int j = 0; j < ck; ++j) { const size_t co = ((size_t)b * 32 + j) * DM + c4 * 4; Hh = *(const f32x4*)(CP + co) * Hh + *(const f32x4*)(CH + co); }
        const size_t base = ((size_t)b * SEQ + ck * 64) * DM + c4 * 4;
#pragma unroll 8
        for (int t = 0; t < 64; ++t) { const size_t o = base + (size_t)t * DM;
            const u32x2 lw = *(const u32x2*)(LA + o), bw = *(const u32x2*)(BTb + o); const u32x2 gw = *(const u32x2*)(GATE + o);
            const f32x4 bt = {bf_lo(bw.x), bf_hi(bw.x), bf_lo(bw.y), bf_hi(bw.y)};
            f32x4 a; a[0] = __expf(bf_lo(lw.x)); a[1] = __expf(bf_hi(lw.x)); a[2] = __expf(bf_lo(lw.y)); a[3] = __expf(bf_hi(lw.y));
            Hh = a * Hh + bt;
            u32x2 w; w.x = cvt_pk_bf16(Hh[0] * bf_lo(gw.x), Hh[1] * bf_hi(gw.x)); w.y = cvt_pk_bf16(Hh[2] * bf_lo(gw.y), Hh[3] * bf_hi(gw.y));
            *(u32x2*)(YG + o) = w; }
    }
}

#define XB_TMO      128
#define XB_XCNT(j)  (256  + 64 * (j))
#define XB_XSUB(j)  (1280 + 64 * (j))
#define XB_XGEN(j)  (2304 + 64 * (j))
#define XB_TOP      3328
#define XB_TOPGEN   3392
#define XCD_BAR_WORDS 3456
#define XB_SPIN_CAP (1u << 18)
__device__ __forceinline__ unsigned xb_ld(unsigned* p)              { return __hip_atomic_load(p, __ATOMIC_RELAXED, __HIP_MEMORY_SCOPE_AGENT); }
__device__ __forceinline__ unsigned xb_add(unsigned* p, unsigned v) { return __hip_atomic_fetch_add(p, v, __ATOMIC_RELAXED, __HIP_MEMORY_SCOPE_AGENT); }
__device__ __forceinline__ unsigned xb_xcc_id() { return (unsigned)__builtin_amdgcn_s_getreg((3 << 11) | 20) & 0xFu; }
#define XB_SPIN(cond, bar) do { unsigned _sp = 0; while (cond) { __builtin_amdgcn_s_sleep(1); \
    if ((++_sp & 255u) == 0u) { if (xb_ld(&(bar)[XB_TMO])) break; if (_sp > XB_SPIN_CAP) { atomicAdd(&(bar)[XB_TMO], 1u); break; } } } } while (0)
struct XcdBarrier { unsigned* bar; unsigned x; volatile LAS unsigned* st; };
__device__ __forceinline__ XcdBarrier xcd_barrier_post(unsigned* bar, volatile LAS unsigned* st) {
    XcdBarrier b; b.bar = bar; b.x = xb_xcc_id(); b.st = st;
    if (threadIdx.x == 0) (void)xb_add(&bar[XB_XCNT(b.x)], 1u);
    return b;
}
__device__ __forceinline__ void xcd_barrier_complete(unsigned* bar, unsigned x, unsigned& nloc, unsigned& nx) {
    const unsigned G = gridDim.x * gridDim.y * gridDim.z;
    unsigned sum, cnt, mine, sp = 0u;
    for (;;) {
        sum = 0u; cnt = 0u; mine = 0u;
#pragma unroll
        for (unsigned j = 0; j < 16; ++j) { const unsigned c = xb_ld(&bar[XB_XCNT(j)]); sum += c; cnt += (c > 0u) ? 1u : 0u; mine = (j == x) ? c : mine; }
        if (sum == G) break;
        __builtin_amdgcn_s_sleep(1);
        if ((++sp & 255u) == 0u) { if (xb_ld(&bar[XB_TMO])) break; if (sp > XB_SPIN_CAP) { atomicAdd(&bar[XB_TMO], 1u); break; } }
    }
    nloc = mine > 0u ? mine : 1u; nx = cnt > 0u ? cnt : 1u;
}
__device__ __forceinline__ void xcd_barrier(const XcdBarrier& b) {
    asm volatile("s_waitcnt vmcnt(0)" ::: "memory");
    __syncthreads();
    if (threadIdx.x == 0) {
        unsigned* bar = b.bar;
        __builtin_amdgcn_s_waitcnt(0);
        unsigned nloc = b.st[0], nx = b.st[1];
        if (nloc == 0u) { xcd_barrier_complete(bar, b.x, nloc, nx); b.st[0] = nloc; b.st[1] = nx; }
        const unsigned old = xb_add(&bar[XB_XSUB(b.x)], 1u);
        const unsigned gen = old / nloc;
        if (old + 1u == (gen + 1u) * nloc) {
            __builtin_amdgcn_fence(__ATOMIC_RELEASE, "agent");
            asm volatile("s_waitcnt vmcnt(0)" ::: "memory");
            const unsigned og = xb_add(&bar[XB_TOP], 1u);
            const unsigned tg = og / nx;
            if (og + 1u == (tg + 1u) * nx) xb_add(&bar[XB_TOPGEN], 1u);
            else XB_SPIN(xb_ld(&bar[XB_TOPGEN]) == tg, bar);
            __builtin_amdgcn_fence(__ATOMIC_ACQUIRE, "agent");
            xb_add(&bar[XB_XGEN(b.x)], 1u);
            asm volatile("s_waitcnt vmcnt(0)" ::: "memory");
        } else {
            XB_SPIN(xb_ld(&bar[XB_XGEN(b.x)]) == gen, bar);
            __builtin_amdgcn_fence(__ATOMIC_ACQUIRE, "agent");
            asm volatile("s_waitcnt vmcnt(0)" ::: "memory");
        }
    }
    __syncthreads();
}

struct Params { const float* in[21]; float* out; unsigned char* ws; int ph_lo, ph_hi; };

__global__ void __launch_bounds__(512) mega(Params p) {
    extern __shared__ __attribute__((aligned(16))) unsigned char smem[];
    cg::grid_group grid = cg::this_grid();
    LAS unsigned char* lds = (LAS unsigned char*)smem;
    unsigned char* ws = p.ws;
    const int G = gridDim.x;
    const float* x_in = p.in[0];
    bf16_t* W_UP = (bf16_t*)(ws + WS_WUP); bf16_t* W_DN = (bf16_t*)(ws + WS_WDN); bf16_t* W_POOL = (bf16_t*)(ws + WS_WPOOL);
    bf16_t* W_AIN = (bf16_t*)(ws + WS_WAIN); bf16_t* W_AO = (bf16_t*)(ws + WS_WAO); bf16_t* W_RIN = (bf16_t*)(ws + WS_WRIN);
    bf16_t* W_RG = (bf16_t*)(ws + WS_WRG); bf16_t* W_RO = (bf16_t*)(ws + WS_WRO);
    float* XB = (float*)(ws + WS_XB); bf16_t* XBF = (bf16_t*)(ws + WS_XBF);
    bf16_t* Hb = (bf16_t*)(ws + WS_H); bf16_t* ACTb = (bf16_t*)(ws + WS_ACT);
    float* SPb = (float*)(ws + WS_SP); float* STS = (float*)(ws + WS_ST); float* FG = (float*)(ws + WS_FG); float* CP = (float*)(ws + WS_CP); float* CH = (float*)(ws + WS_CH);
    bf16_t* DB = Hb;
    bf16_t* Qb = Hb; bf16_t* Kb = (bf16_t*)(ws + WS_H + TD2); bf16_t* Vb = (bf16_t*)(ws + WS_H + 2 * TD2); bf16_t* Ob = ACTb;
    bf16_t* XBR = Hb; bf16_t* GATE = (bf16_t*)(ws + WS_H + TD2); bf16_t* XBC = (bf16_t*)(ws + WS_H + 2 * TD2); bf16_t* BTb = (bf16_t*)(ws + WS_H + 3 * TD2);
    bf16_t* LA = (bf16_t*)(ws + WS_ACT); bf16_t* YG = Hb;

    volatile LAS unsigned* xst = (volatile LAS unsigned*)(lds + 131072 + 16384 + 32);
    if (threadIdx.x == 0) { xst[0] = 0u; xst[1] = 0u; }
    __syncthreads();
    XcdBarrier xbar; xbar.bar = (unsigned*)(ws + WS_BAR); xbar.x = 0; xbar.st = xst;
    if (!MK_MULTI) xbar = xcd_barrier_post((unsigned*)(ws + WS_BAR), xst);
    int ph = 0; const int lo = p.ph_lo, hi = p.ph_hi;
#define RUN(...) do { if (ph >= lo && ph < hi) { __VA_ARGS__; if (ph + 1 < hi) { if (ph == lo) grid.sync(); else xcd_barrier(xbar); } } ++ph; } while (0)

    RUN({
        float* tile = (float*)smem;
        for (int l = 0; l < 4; ++l) convT(tile, p.in[17] + (size_t)l * DM * FF2, DM, FF2, FF2, W_UP + (size_t)l * FF2 * DM, l * 64);
        for (int l = 0; l < 4; ++l) convT(tile, p.in[20] + (size_t)l * FF * DM, FF, DM, DM, W_DN + (size_t)l * DM * FF, l * 64 + 32);
        for (int lg = 0; lg < 8; ++lg) convT(tile, p.in[1] + (size_t)lg * 512 * 512, 512, 512, 512, W_POOL + (size_t)lg * 512 * 512, lg * 16);
        convT(tile, p.in[3], DM, 3 * DM + NH, NQKV, W_AIN, 128);
        convT(tile, p.in[5], DM, DM, DM, W_AO, 160);
        convT(tile, p.in[6], DM, 2 * DM, 2 * DM, W_RIN, 192);
        convT(tile, p.in[14], DM, DM, DM, W_RO, 224);
        conv_gates(p.in[9], p.in[11], W_RG);
        for (int i = my_bid() * 512 + my_tid(); i < DM; i += G * 512) SPb[i] = log1pf(__expf(-p.in[13][i]));
        pool_diff(x_in, DB);
    });

    const float* R = x_in;
    int s = 0;
    for (int layer = 0; layer < 4; ++layer) {
        const int kind = layer % 3;
        pg8::Gemm gm;
        const float* cs = nullptr;
        if (kind == 0) {
            const int j = layer / 3;
            if (layer > 0) RUN({ pool_diff(R, DB); });
            gm = pg8::Gemm{DB, W_POOL + (size_t)j * DM * 512, 512, DM, 512, 2, 512}; cs = p.in[2] + (size_t)j * DM;
        } else if (kind == 1) {
            RUN({ pg8::Gemm g{XBF, W_AIN, DM, DM, DM, 1 << 20, 0}; pg8::StaticOrder S; S.init(T, NQKV, G, my_bid());
                  pg8::EpiGen E{Qb, DM, 1, FG}; pg8::gemm_phase<pg8::EpiGen>(lds, g, S, E); });
            RUN({ att::attn_phase((char*)smem, Qb, Kb, Vb, Ob, FG, p.in[4]); });
            gm = pg8::Gemm{Ob, W_AO, DM, DM, DM, 1 << 20, 0};
        } else {
            RUN({ pg8::Gemm g{XBF, W_RIN, DM, DM, DM, 1 << 20, 0}; pg8::StaticOrder S; S.init(T, 2 * DM, G, my_bid());
                  pg8::EpiGen E{XBR, DM, 2, nullptr}; pg8::gemm_phase<pg8::EpiGen>(lds, g, S, E); });
            RUN({ conv4_phase(XBR, p.in[7], p.in[8], XBC); });
            RUN({ pg8::Gemm g{XBC, W_RG, 256, DM, 256, 2, 256}; pg8::StaticOrder S; S.init(T, 4096, G, my_bid());
                  pg8::EpiGates E{p.in[10], p.in[12], SPb, XBC, LA, BTb}; pg8::gemm_phase<pg8::EpiGates>(lds, g, S, E); });
            RUN({ scan1_phase(LA, BTb, CP, CH); });
            RUN({ scan2_phase(LA, BTb, CP, CH, GATE, YG); });
            gm = pg8::Gemm{YG, W_RO, DM, DM, DM, 1 << 20, 0};
        }
        for (int sub = 0; sub < 2; ++sub) {
            if (sub == 1) {
                RUN({ pg8::Gemm g{XBF, W_UP + (size_t)layer * FF2 * DM, DM, DM, DM, 1 << 20, 0}; pg8::StaticOrder S; S.init(T, FF2, G, my_bid());
                      pg8::EpiGen E{Hb, FF2, 0, nullptr}; pg8::gemm_phase<pg8::EpiGen>(lds, g, S, E); });
                RUN({ convgate_phase(Hb, p.in[18] + (size_t)layer * 3 * FF2, p.in[19] + (size_t)layer * FF2, ACTb); });
                gm = pg8::Gemm{ACTb, W_DN + (size_t)layer * DM * FF, FF, FF, FF, 1 << 20, 0}; cs = nullptr;
            }
            float* Y = (s & 1) ? p.out : XB;
            const bool rawR = (s == 0 || s == 6);
            RUN({ pg8::StaticOrder S; S.init(T, DM, G, my_bid());
                  pg8::EpiRes E{R, Y, cs, rawR ? nullptr : STS, p.in[15] + (size_t)(s > 0 ? s - 1 : 0) * DM, p.in[16] + (size_t)(s > 0 ? s - 1 : 0) * DM};
                  pg8::gemm_phase<pg8::EpiRes>(lds, gm, S, E); });
            RUN({ ln_phase(Y, p.in[15] + (size_t)s * DM, p.in[16] + (size_t)s * DM, XBF, STS, s == 5 || s == 7); });
            R = Y; ++s;
        }
    }
#undef RUN
}

constexpr int N_PHASES = 1 + 6 + 8 + 11 + 7;

extern "C" void kernel_launch(void* const* d_in, const int* in_sizes, int n_in, void* d_out, int out_size, void* d_ws, size_t ws_size, hipStream_t stream) {
    static int grid = 0;
    if (grid == 0) {
        if (n_in != 21 || out_size != T * DM || ws_size < WS_END) { fprintf(stderr, "kernel_launch: unexpected shapes (n_in %d out %d ws %zu)\n", n_in, out_size, ws_size); grid = -1; return; }
        int dev = 0, cus = 0, per_cu = 0;
        (void)hipGetDevice(&dev);
        if (hipDeviceGetAttribute(&cus, hipDeviceAttributeMultiprocessorCount, dev) != hipSuccess || cus <= 0) cus = 256;
        if (hipFuncSetAttribute((const void*)mega, hipFuncAttributeMaxDynamicSharedMemorySize, LDS_BYTES) != hipSuccess) { fprintf(stderr, "kernel_launch: hipFuncSetAttribute failed\n"); grid = -1; return; }
        if (hipOccupancyMaxActiveBlocksPerMultiprocessor(&per_cu, (const void*)mega, 512, LDS_BYTES) != hipSuccess || per_cu < 1) { fprintf(stderr, "kernel_launch: occupancy query says %d\n", per_cu); per_cu = 1; }
        (void)hipGetLastError();
        grid = cus;
    }
    if (grid < 0) return;
    Params p{};
    for (int i = 0; i < 21; ++i) p.in[i] = (const float*)d_in[i];
    p.out = (float*)d_out; p.ws = (unsigned char*)d_ws;
#if MK_MULTI
    for (int k = 0; k < N_PHASES; ++k) { p.ph_lo = k; p.ph_hi = k + 1; hipLaunchKernelGGL(mega, dim3(grid), dim3(512), LDS_BYTES, stream, p); }
#else
    p.ph_lo = 0; p.ph_hi = N_PHASES;
    (void)hipMemsetAsync((char*)d_ws + WS_BAR, 0, XCD_BAR_WORDS * 4, stream);
    void* args[] = {&p};
    hipError_t e = hipLaunchCooperativeKernel((const void*)mega, dim3(grid), dim3(512), args, LDS_BYTES, stream);
    if (e != hipSuccess) fprintf(stderr, "kernel_launch: cooperative launch failed: %s (grid %d)\n", hipGetErrorString(e), grid);
#endif
}
```

```cpp
#include <hip/hip_runtime.h>
#include <hip/hip_bf16.h>
#include <hip/hip_cooperative_groups.h>
#include <cstdio>
#include <cstdint>
namespace cg = cooperative_groups;

#ifndef MK_MULTI
#define MK_MULTI 0
#endif

#define LAS __attribute__((address_space(3)))
typedef unsigned short bf16_t;
typedef short bf16x8 __attribute__((ext_vector_type(8)));
typedef short s16x4 __attribute__((ext_vector_type(4)));
typedef float f32x2 __attribute__((ext_vector_type(2)));
typedef float f32x4 __attribute__((ext_vector_type(4)));
typedef float f32x16 __attribute__((ext_vector_type(16)));
typedef unsigned u32x2 __attribute__((ext_vector_type(2)));
typedef unsigned u32x4 __attribute__((ext_vector_type(4)));

constexpr int NB = 8, SEQ = 2048, DM = 2048, T = NB * SEQ, FF = 5632, FF2 = 2 * FF, NH = 16;
constexpr float LN_EPS = 1e-5f;
constexpr float ALPHA = 1.681792830507429f;
constexpr int NQKV = 6400;

constexpr size_t MiB = 1ull << 20;
constexpr size_t WS_WUP = 0, WUP_L = (size_t)FF2 * DM * 2;
constexpr size_t WS_WDN = 176 * MiB, WDN_L = (size_t)DM * FF * 2;
constexpr size_t WS_WPOOL = 264 * MiB;
constexpr size_t WS_WAIN = 268 * MiB;
constexpr size_t WS_WAO = 293 * MiB;
constexpr size_t WS_WRIN = 301 * MiB;
constexpr size_t WS_WRG = 317 * MiB;
constexpr size_t WS_WRO = 319 * MiB;
constexpr size_t WS_XB = 327 * MiB;
constexpr size_t WS_XBF = 455 * MiB;
constexpr size_t WS_H = 519 * MiB;
constexpr size_t WS_ACT = 871 * MiB;
constexpr size_t WS_FG = 1047 * MiB;
constexpr size_t WS_CP = 1048 * MiB;
constexpr size_t WS_CH = 1050 * MiB;
constexpr size_t WS_SP = 1052 * MiB;
constexpr size_t WS_BAR = 1053 * MiB;
constexpr size_t WS_ST = 1054 * MiB;
constexpr size_t WS_END = 1055 * MiB;
constexpr size_t TD2 = (size_t)T * DM * 2;

constexpr int LDS_BYTES = 131072 + 16384 + 64;

__device__ __forceinline__ int my_tid() { int t = threadIdx.x; asm volatile("" : "+v"(t)); return t; }
__device__ __forceinline__ int my_bid() { int b = blockIdx.x; asm volatile("" : "+s"(b)); return b; }
__device__ __forceinline__ int my_grid() { int g = gridDim.x; asm volatile("" : "+s"(g)); return g; }
__device__ __forceinline__ unsigned cvt_pk_bf16(float lo, float hi) { unsigned r; asm volatile("v_cvt_pk_bf16_f32 %0, %1, %2" : "=v"(r) : "v"(lo), "v"(hi)); return r; }
__device__ __forceinline__ float bf_lo(unsigned u) { return __uint_as_float(u << 16); }
__device__ __forceinline__ float bf_hi(unsigned u) { return __uint_as_float(u & 0xffff0000u); }

namespace pg8 {
constexpr int BM = 256, BK = 64, HALF = 128, HTB = HALF * BK * 2, STAGE_BYTES = 8 * HTB, NXCD = 8, WGM = 8;
__device__ __forceinline__ int lds_byte(int r, int c) { const int st = (r >> 4) * 2 + (c >> 5), rr = r & 15, cc = c & 31, ob = rr * 64 + cc * 2; return st * 1024 + (ob ^ (((ob >> 9) & 1) << 5)); }
__device__ __forceinline__ void stage_rc(int b, int& R, int& C) { const int st = b / 1024, sb = b % 1024, swz = sb ^ (((sb >> 9) & 1) << 5); R = (st >> 1) * 16 + swz / 64; C = (st & 1) * 32 + (swz % 64) / 2; }
__device__ __forceinline__ int perm32(int rho) { const int n = rho >> 4, i = rho & 15; return 8 * (i >> 2) + 4 * n + (i & 3); }

struct Unit { int pm, pn; };
struct Gemm { const bf16_t* A; const bf16_t* Bt; int K, lda, ldb, tpg, a_gs; };

struct StaticOrder {
    int nM, nN, nwg, G, c;
    __device__ void init(int M, int N, int G_, int c_) { nM = M / BM; nN = N / BM; nwg = nM * nN; G = G_; c = c_; }
    __device__ bool next(int i, Unit& u) const {
        const long L = (long)i * G + c; if (L >= nwg) return false;
        int wgid = (int)L; { const int q = nwg / NXCD, r = nwg % NXCD, xcd = wgid % NXCD, off = wgid / NXCD; wgid = (xcd < r ? xcd * (q + 1) : r * (q + 1) + (xcd - r) * q) + off; }
        const int nig = WGM * nN, gid = wgid / nig, fm = gid * WGM, gsz = (nM - fm) < WGM ? (nM - fm) : WGM;
        u.pm = fm + ((wgid % nig) % gsz); u.pn = (wgid % nig) / gsz; return true;
    }
};

template <class Epi>
__device__ __forceinline__ void gemm_phase(LAS unsigned char* lds, const Gemm g, const StaticOrder& S, const Epi& E) {
    const int tid = my_tid(), wid = __builtin_amdgcn_readfirstlane(tid >> 6), lane = tid & 63, wr = wid >> 2, wc = wid & 3, fr = lane & 15, fq = lane >> 4;
    int K = g.K, lda_ = g.lda, ldb_ = g.ldb; asm volatile("" : "+s"(K), "+s"(lda_), "+s"(ldb_));
    const int nt = K / BK;
    unsigned voffA[2], voffB[2];
#pragma unroll
    for (int i = 0; i < 2; ++i) { int R, C; stage_rc(tid * 16 + i * 8192, R, C); const int Rb = Epi::PERM ? ((R & ~31) + perm32(R & 31)) : R;
        voffA[i] = (unsigned)(R * lda_ + C) * 2u; voffB[i] = (unsigned)(Rb * ldb_ + C) * 2u; }
    const size_t kstep = (size_t)(BK * 2);
    const size_t hstepA = (size_t)HALF * lda_ * 2, hstepB = (size_t)HALF * ldb_ * 2;
    const unsigned ldsw = (unsigned)wid * 1024u;
    const int aoff = lds_byte(wr * 64 + fr, fq * 8), boff = lds_byte(wc * 32 + fr, fq * 8);
#define PG8_SA(b, h) (((b) * 2 + (h)) * HTB)
#define PG8_SB(b, h) ((4 + (b) * 2 + (h)) * HTB)
#define PG8_STAGE(bufoff, gbase, voff) do { _Pragma("unroll") for (int _i = 0; _i < 2; ++_i) \
        __builtin_amdgcn_global_load_lds((const unsigned*)((const char*)(gbase) + (voff)[_i]), (LAS unsigned*)(lds + (bufoff) + ldsw + _i * 8192), 16, 0, 0); } while (0)
#define PG8_LDA(dst, b, h) do { _Pragma("unroll") for (int m = 0; m < 4; ++m) _Pragma("unroll") for (int k = 0; k < 2; ++k) dst[m][k] = *(const LAS bf16x8*)(lds + PG8_SA(b, h) + aoff + m * 2048 + k * 1024); } while (0)
#define PG8_LDB(dst, b, h) do { _Pragma("unroll") for (int n = 0; n < 2; ++n) _Pragma("unroll") for (int k = 0; k < 2; ++k) dst[n][k] = *(const LAS bf16x8*)(lds + PG8_SB(b, h) + boff + n * 2048 + k * 1024); } while (0)
#define PG8_MMA(ai, bj, At, Bt) do { __builtin_amdgcn_s_setprio(1); _Pragma("unroll") for (int m = 0; m < 4; ++m) _Pragma("unroll") for (int n = 0; n < 2; ++n) _Pragma("unroll") for (int k = 0; k < 2; ++k) \
        acc[ai][bj][m][n] = __builtin_amdgcn_mfma_f32_16x16x32_bf16(Bt[n][k], At[m][k], acc[ai][bj][m][n], 0, 0, 0); __builtin_amdgcn_s_setprio(0); } while (0)
#define PG8_WAIT_V(n) asm volatile("s_waitcnt vmcnt(" #n ")" ::: "memory")
#define PG8_WAIT_L(n) asm volatile("s_waitcnt lgkmcnt(" #n ")" ::: "memory")
#define PG8_BAR __builtin_amdgcn_s_barrier()
#define PG8_SCHED __builtin_amdgcn_sched_barrier(0)
#define PG8_ABASE(u) ((const char*)g.A + ((size_t)((u).pn / g.tpg) * g.a_gs) * 2 + (size_t)(u).pm * 2 * hstepA)
#define PG8_BBASE(u) ((const char*)g.Bt + (size_t)(u).pn * 2 * hstepB)
    Unit cur, nxt; int ui = 0;
    if (!S.next(0, cur)) return;
    f32x4 acc[2][2][4][2];
#pragma unroll
    for (int a = 0; a < 2; ++a)
#pragma unroll
        for (int b = 0; b < 2; ++b)
#pragma unroll
            for (int m = 0; m < 4; ++m)
#pragma unroll
                for (int n = 0; n < 2; ++n) acc[a][b][m][n] = (f32x4){0.f, 0.f, 0.f, 0.f};
    bf16x8 At[4][2], B0[2][2], B1[2][2];
    const char* cA = PG8_ABASE(cur); const char* cB = PG8_BBASE(cur);
    PG8_STAGE(PG8_SB(0, 0), cB, voffB); PG8_STAGE(PG8_SA(0, 0), cA, voffA); PG8_STAGE(PG8_SB(0, 1), cB + hstepB, voffB); PG8_STAGE(PG8_SA(0, 1), cA + hstepA, voffA);
    if (wr == 1) PG8_BAR;
    PG8_WAIT_V(4); PG8_BAR;
    PG8_STAGE(PG8_SB(1, 0), cB + kstep, voffB); PG8_STAGE(PG8_SA(1, 0), cA + kstep, voffA); PG8_STAGE(PG8_SB(1, 1), cB + hstepB + kstep, voffB);
    PG8_WAIT_V(6); PG8_BAR;
    for (;;) {
        const bool has_next = S.next(ui + 1, nxt);
        const char* nA = has_next ? PG8_ABASE(nxt) : cA; const char* nB = has_next ? PG8_BBASE(nxt) : cB;
        for (int t = 0; t < nt; t += 2) {
            const bool last = (t == nt - 2);
            const char* a1 = cA + (size_t)(t + 1) * kstep;
            const char* a2 = last ? nA : cA + (size_t)(t + 2) * kstep; const char* b2 = last ? nB : cB + (size_t)(t + 2) * kstep;
            const char* a3 = a2 + kstep; const char* b3 = b2 + kstep;
            PG8_LDB(B0, 0, 0); PG8_SCHED; PG8_LDA(At, 0, 0); PG8_STAGE(PG8_SA(1, 1), a1 + hstepA, voffA);
            PG8_WAIT_L(8); PG8_BAR; PG8_WAIT_L(0); PG8_MMA(0, 0, At, B0); PG8_BAR; PG8_SCHED;
            PG8_LDB(B1, 0, 1); PG8_STAGE(PG8_SB(0, 0), b2, voffB);
            PG8_BAR; PG8_WAIT_L(0); PG8_MMA(0, 1, At, B1); PG8_BAR;
            PG8_LDA(At, 0, 1); PG8_STAGE(PG8_SA(0, 0), a2, voffA);
            PG8_BAR; PG8_WAIT_L(0); PG8_MMA(1, 0, At, B0); PG8_BAR; PG8_SCHED;
            PG8_STAGE(PG8_SB(0, 1), b2 + hstepB, voffB);
            PG8_WAIT_V(6); PG8_BAR; PG8_MMA(1, 1, At, B1); PG8_BAR;
            PG8_LDB(B0, 1, 0); PG8_SCHED; PG8_LDA(At, 1, 0); PG8_STAGE(PG8_SA(0, 1), a2 + hstepA, voffA);
            PG8_WAIT_L(8); PG8_BAR; PG8_WAIT_L(0); PG8_MMA(0, 0, At, B0); PG8_BAR; PG8_SCHED;
            PG8_LDB(B1, 1, 1); PG8_STAGE(PG8_SB(1, 0), b3, voffB);
            PG8_BAR; PG8_WAIT_L(0); PG8_MMA(0, 1, At, B1); PG8_BAR;
            PG8_LDA(At, 1, 1); PG8_STAGE(PG8_SA(1, 0), a3, voffA);
            PG8_BAR; PG8_WAIT_L(0); PG8_MMA(1, 0, At, B0); PG8_BAR; PG8_SCHED;
            PG8_STAGE(PG8_SB(1, 1), b3 + hstepB, voffB);
            PG8_WAIT_V(6); PG8_BAR; PG8_MMA(1, 1, At, B1); PG8_BAR;
        }
        E(acc, cur, wr, wc, fr, fq);
        if (!has_next) break;
#pragma unroll
        for (int a = 0; a < 2; ++a)
#pragma unroll
            for (int b = 0; b < 2; ++b)
#pragma unroll
                for (int m = 0; m < 4; ++m)
#pragma unroll
                    for (int n = 0; n < 2; ++n) acc[a][b][m][n] = (f32x4){0.f, 0.f, 0.f, 0.f};
        cur = nxt; cA = nA; cB = nB; ++ui;
    }
    PG8_WAIT_V(0);
    if (wr == 0) PG8_BAR;
    PG8_BAR;
#undef PG8_SA
#undef PG8_SB
#undef PG8_STAGE
#undef PG8_LDA
#undef PG8_LDB
#undef PG8_MMA
#undef PG8_WAIT_V
#undef PG8_WAIT_L
#undef PG8_BAR
#undef PG8_SCHED
#undef PG8_ABASE
#undef PG8_BBASE
}


struct EpiRes {
    static constexpr bool PERM = true;
    const float* R; float* Y; const float* cs; const float* pst; const float* pg; const float* pb;
    __device__ __forceinline__ void operator()(const f32x4 (&acc)[2][2][4][2], const Unit& u, int wr, int wc, int fr, int fq) const {
        asm volatile("" : "+v"(fr), "+v"(fq));
        const int urow = u.pm * BM + wr * 64, ucol = u.pn * BM + wc * 32;
        const unsigned l4 = (unsigned)(fr * DM + 8 * fq) * 4u, ls = (unsigned)fr * 8u, lc = (unsigned)fq * 32u;
#pragma unroll
        for (int ai = 0; ai < 2; ++ai) {
#pragma unroll
            for (int bj = 0; bj < 2; ++bj) { const int cu = ucol + bj * HALF;
                f32x4 g0 = {1.f, 1.f, 1.f, 1.f}, g1 = g0, b0 = {0.f, 0.f, 0.f, 0.f}, b1 = b0, c0 = g0, c1v = g0;
                if (pst) { const char* gp = (const char*)(pg + cu) + lc; const char* bp = (const char*)(pb + cu) + lc;
                    g0 = *(const f32x4*)gp; g1 = *(const f32x4*)(gp + 16); b0 = *(const f32x4*)bp; b1 = *(const f32x4*)(bp + 16); }
                if (cs) { const char* cp = (const char*)(cs + cu) + lc; c0 = *(const f32x4*)cp; c1v = *(const f32x4*)(cp + 16); }
                f32x4 r0[4], r1[4]; f32x2 sv[4];
#pragma unroll
                for (int m = 0; m < 4; ++m) { const size_t uo = (size_t)(urow + ai * HALF + m * 16) * DM + cu;
                    const char* rp = (const char*)(R + uo) + l4; r0[m] = *(const f32x4*)rp; r1[m] = *(const f32x4*)(rp + 16);
                    sv[m] = pst ? *(const f32x2*)((const char*)(pst + (size_t)(urow + ai * HALF + m * 16) * 2) + ls) : (f32x2){0.f, 1.f}; }
#pragma unroll
                for (int m = 0; m < 4; ++m) { const size_t uo = (size_t)(urow + ai * HALF + m * 16) * DM + cu;
                    f32x4 q0 = r0[m], q1 = r1[m];
                    if (pst) { q0 = (q0 - sv[m].x) * sv[m].y * g0 + b0; q1 = (q1 - sv[m].x) * sv[m].y * g1 + b1; }
                    char* yp = (char*)(Y + uo) + l4;
                    *(f32x4*)yp = q0 * ALPHA + acc[ai][bj][m][0] * c0; *(f32x4*)(yp + 16) = q1 * ALPHA + acc[ai][bj][m][1] * c1v; }
                asm volatile("" ::: "memory"); }
        }
    }
};

__device__ __forceinline__ float gelu_tanh(float x) {
    const float u = 0.7978845608028654f * (x + 0.044715f * x * x * x);
    const float e = __expf(2.f * u);
    const float th = 1.f - 2.f * __builtin_amdgcn_rcpf(1.f + e);
    return 0.5f * x * (1.f + th);
}

struct EpiGen {
    static constexpr bool PERM = true;
    bf16_t* O; int ldc; int mode; float* FG;
    __device__ __forceinline__ void operator()(const f32x4 (&acc)[2][2][4][2], const Unit& u, int wr, int wc, int fr, int fq) const {
        asm volatile("" : "+v"(fr), "+v"(fq));
        const int row0 = u.pm * BM + wr * 64 + fr; const int pn = u.pn;
        bf16_t* base = O; int ld = ldc; int colt = pn * BM; bool act = false;
        if (mode == 1) {
            if (pn == 24) {
                if (wc == 0 && fq < 2) {
#pragma unroll
                    for (int ai = 0; ai < 2; ++ai)
#pragma unroll
                        for (int m = 0; m < 4; ++m) { float* p = FG + (size_t)(row0 + ai * HALF + m * 16) * 16 + 8 * fq;
                            *(f32x4*)p = acc[ai][0][m][0]; *(f32x4*)(p + 4) = acc[ai][0][m][1]; }
                }
                return;
            }
            base = O + (size_t)(pn >> 3) * ((size_t)T * DM); colt = (pn & 7) * BM;
        } else if (mode == 2) {
            base = O + (size_t)(pn >> 3) * ((size_t)T * DM); colt = (pn & 7) * BM; act = (pn >= 8);
        }
        const int col0 = colt + wc * 32 + 8 * fq;
#pragma unroll
        for (int ai = 0; ai < 2; ++ai)
#pragma unroll
            for (int m = 0; m < 4; ++m) { bf16_t* rowp = base + (size_t)(row0 + ai * HALF + m * 16) * ld + col0;
#pragma unroll
                for (int bj = 0; bj < 2; ++bj) { f32x4 v0 = acc[ai][bj][m][0], v1 = acc[ai][bj][m][1];
                    if (act) {
#pragma unroll
                        for (int j = 0; j < 4; ++j) { v0[j] = gelu_tanh(v0[j]); v1[j] = gelu_tanh(v1[j]); } }
                    u32x4 w; w.x = cvt_pk_bf16(v0[0], v0[1]); w.y = cvt_pk_bf16(v0[2], v0[3]); w.z = cvt_pk_bf16(v1[0], v1[1]); w.w = cvt_pk_bf16(v1[2], v1[3]);
                    *(u32x4*)(rowp + bj * HALF) = w; } }
    }
};

struct EpiGates {
    static constexpr bool PERM = false;
    const float* b_a; const float* b_i; const float* SP; const bf16_t* XBC; bf16_t* LA; bf16_t* BTb;
    __device__ __forceinline__ void operator()(const f32x4 (&acc)[2][2][4][2], const Unit& u, int wr, int wc, int fr, int fq) const {
        asm volatile("" : "+v"(fr), "+v"(fq));
        const int row0 = u.pm * BM + wr * 64 + fr, ch0 = u.pn * 128 + wc * 32 + 4 * fq;
#pragma unroll
        for (int n = 0; n < 2; ++n) {
            const f32x4 ba = *(const f32x4*)(b_a + ch0 + 16 * n), bi = *(const f32x4*)(b_i + ch0 + 16 * n), sp = *(const f32x4*)(SP + ch0 + 16 * n);
#pragma unroll
            for (int ai = 0; ai < 2; ++ai)
#pragma unroll
                for (int m = 0; m < 4; ++m) { const int t = row0 + ai * HALF + m * 16; const bool first = (t & (SEQ - 1)) == 0;
                    const size_t off = (size_t)t * DM + ch0 + 16 * n;
                    const u32x2 xw = *(const u32x2*)(XBC + off); const float xb[4] = {bf_lo(xw.x), bf_hi(xw.x), bf_lo(xw.y), bf_hi(xw.y)};
                    f32x4 av, bv;
#pragma unroll
                    for (int j = 0; j < 4; ++j) {
                        const float r = __builtin_amdgcn_rcpf(1.f + __expf(-(acc[ai][0][m][n][j] + ba[j])));
                        const float ig = __builtin_amdgcn_rcpf(1.f + __expf(-(acc[ai][1][m][n][j] + bi[j])));
                        const float la = -8.f * r * sp[j];
                        const float a = __expf(la);
                        const float z = 2.f * la;
                        const float ser = -z * (1.f + 0.5f * z * (1.f + (1.f / 3.f) * z * (1.f + 0.25f * z)));
                        const float em = (z > -0.1f) ? ser : (1.f - a * a);
                        const float mult = first ? 1.f : sqrtf(em);
                        av[j] = la; bv[j] = mult * ig * xb[j]; }
                    u32x2 wa, wb; wa.x = cvt_pk_bf16(av[0], av[1]); wa.y = cvt_pk_bf16(av[2], av[3]); wb.x = cvt_pk_bf16(bv[0], bv[1]); wb.y = cvt_pk_bf16(bv[2], bv[3]);
                    *(u32x2*)(LA + off) = wa; *(u32x2*)(BTb + off) = wb;
                    asm volatile("" ::: "memory"); }
        }
    }
};
}

namespace att {
constexpr int D = 128, RS = DM, W = SEQ;
constexpr float SCALE = 0.08838834764831845f, THR = 24.f;
constexpr int NW = 8, QBLK = 32, KVBLK = 64, QB = NW * QBLK;
constexpr int SHM_V = KVBLK * D * 2, SHM_K = KVBLK * D * 2;
constexpr int ATT_LDS = 2 * SHM_V + 2 * SHM_K + NW * 64 * 4;
using bf16 = bf16_t;
#define KSWZ(row, colB) ((row) * 256 + ((colB) ^ (((row) & 7) << 4)))
#define SBAR() __builtin_amdgcn_sched_barrier(0)
__device__ __forceinline__ int v_st(int k, int c) { const int kk = (k & ~0xC) | ((k & 4) << 1) | ((k & 8) >> 1); return ((kk >> 3) * 4 + (c >> 5)) * 512 + ((kk & 7) * 32 + (c & 31)) * 2; }
__device__ __forceinline__ int v_rd_base(int lane) { return ((lane & 3) << 3) | (((lane >> 2) & 3) << 6) | (((lane >> 4) & 1) << 5) | (((lane >> 5) & 1) << 8); }
constexpr int v_rd_off(int d0, int ks, int half) { return d0 * 512 + ks * 4096 + half * 2048; }
__device__ __forceinline__ int crow(int r, int hi) { return (r & 3) + 8 * (r >> 2) + 4 * hi; }
__device__ __forceinline__ bf16x8 load8(const bf16* p) { return *reinterpret_cast<const bf16x8*>(p); }
__device__ __forceinline__ void mask_tile(f32x16& p0, f32x16& p1, int dq, unsigned Wm) {
    const float NEG = -__builtin_inff();
#pragma unroll
    for (int r = 0; r < 16; ++r) {
        const int c = (r & 3) + 8 * (r >> 2);
        if ((unsigned)(dq - c) >= Wm) p0[r] = NEG;
        if ((unsigned)(dq - c - 32) >= Wm) p1[r] = NEG;
    }
}
__device__ __forceinline__ void partialSM(f32x16& p0, f32x16& p1, float& m_reg, float& mn, float& alpha) {
    float pmax = p0[0];
#pragma unroll
    for (int r = 1; r < 16; ++r) pmax = fmaxf(pmax, p0[r]);
#pragma unroll
    for (int r = 0; r < 16; ++r) pmax = fmaxf(pmax, p1[r]);
    { auto rr = __builtin_amdgcn_permlane32_swap(__float_as_uint(pmax), __float_as_uint(pmax), false, false);
      pmax = fmaxf(__uint_as_float(rr[0]), __uint_as_float(rr[1])); }
    constexpr float C2 = 1.4426950408889634f * SCALE;
    if (__builtin_expect(__all((pmax - m_reg) * SCALE <= THR), 1)) { mn = m_reg; alpha = 1.f; }
    else { mn = fmaxf(m_reg, pmax); alpha = __builtin_amdgcn_exp2f((m_reg - mn) * C2); m_reg = mn; }
    const float mnL = -mn * C2;
#pragma unroll
    for (int r = 0; r < 16; ++r) p0[r] = fmaf(p0[r], C2, mnL);
#pragma unroll
    for (int r = 0; r < 16; ++r) p1[r] = fmaf(p1[r], C2, mnL);
#pragma unroll
    for (int r = 0; r < 16; ++r) p0[r] = __builtin_amdgcn_exp2f(p0[r]);
}
__device__ __forceinline__ void finishSM(f32x16& p0, f32x16& p1, float alpha, float& l_reg, bf16x8& pa0, bf16x8& pa1, bf16x8& pa2, bf16x8& pa3) {
#pragma unroll
    for (int r = 0; r < 16; ++r) p1[r] = __builtin_amdgcn_exp2f(p1[r]);
    float ps = 0;
#pragma unroll
    for (int r = 0; r < 16; ++r) ps += p0[r];
#pragma unroll
    for (int r = 0; r < 16; ++r) ps += p1[r];
    { auto rr = __builtin_amdgcn_permlane32_swap(__float_as_uint(ps), __float_as_uint(ps), false, false);
      ps = __uint_as_float(rr[0]) + __uint_as_float(rr[1]); }
    l_reg = l_reg * alpha + ps;
#define PK4(P, B_, OUT) do { unsigned a0 = cvt_pk_bf16(P[B_+0], P[B_+1]), a1 = cvt_pk_bf16(P[B_+2], P[B_+3]);                          \
        unsigned b0 = cvt_pk_bf16(P[B_+4], P[B_+5]), b1 = cvt_pk_bf16(P[B_+6], P[B_+7]);                                             \
        auto r0 = __builtin_amdgcn_permlane32_swap(a0, b0, false, false); auto r1 = __builtin_amdgcn_permlane32_swap(a1, b1, false, false); \
        u32x4 w = {r0[0], r1[0], r0[1], r1[1]}; OUT = *reinterpret_cast<bf16x8*>(&w); } while (0)
    PK4(p0, 0, pa0); PK4(p0, 8, pa1); PK4(p1, 0, pa2); PK4(p1, 8, pa3);
#undef PK4
}
template <int KB>
__device__ __forceinline__ void qkt(f32x16& p0, f32x16& p1, const char* K_lds, int r32, int hi, const bf16x8* qr, const float* bt) {
#pragma unroll
    for (int g = 0; g < 4; ++g) { const f32x4 x0 = *(const f32x4*)(bt + 8 * g), x1 = *(const f32x4*)(bt + 32 + 8 * g);
#pragma unroll
        for (int j = 0; j < 4; ++j) { p0[4 * g + j] = x0[j]; p1[4 * g + j] = x1[j]; } }
    const char* kb[4];
#pragma unroll
    for (int dd = 0; dd < 4; ++dd) kb[dd] = K_lds + KB * SHM_K + KSWZ(r32, (dd * 16 + hi * 8) * 2);
#pragma unroll
    for (int d0 = 0; d0 < 8; ++d0) { const char* a = kb[d0 & 3] + (d0 >> 2) * 128;
        bf16x8 b0 = *reinterpret_cast<const bf16x8*>(a);
        bf16x8 b1 = *reinterpret_cast<const bf16x8*>(a + 32 * 256);
        p0 = __builtin_amdgcn_mfma_f32_32x32x16_bf16(b0, qr[d0], p0, 0, 0, 0);
        p1 = __builtin_amdgcn_mfma_f32_32x32x16_bf16(b1, qr[d0], p1, 0, 0, 0); }
}
template <int VB>
__device__ __forceinline__ void pv_tile(f32x16* o, int vb0, bf16x8 pa0, bf16x8 pa1, bf16x8 pa2, bf16x8 pa3) {
#define TRRD(dst, off) asm volatile("ds_read_b64_tr_b16 %0, %1 offset:%2" : "=&v"(dst) : "v"(vb0), "i"(off) : "memory")
#define PV_D0(d0) do { s16x4 l0, l1, l2, l3, h0, h1, h2, h3; constexpr int b_ = VB * SHM_V + v_rd_off(d0, 0, 0); \
        TRRD(l0, b_); TRRD(h0, b_ + 2048); TRRD(l1, b_ + 4096); TRRD(h1, b_ + 6144); TRRD(l2, b_ + 8192); TRRD(h2, b_ + 10240); TRRD(l3, b_ + 12288); TRRD(h3, b_ + 14336); \
        asm volatile("s_waitcnt lgkmcnt(0)" ::: "memory"); SBAR();   \
        o[d0] = __builtin_amdgcn_mfma_f32_32x32x16_bf16(pa0, (bf16x8){l0[0], l0[1], l0[2], l0[3], h0[0], h0[1], h0[2], h0[3]}, o[d0], 0, 0, 0);   \
        o[d0] = __builtin_amdgcn_mfma_f32_32x32x16_bf16(pa1, (bf16x8){l1[0], l1[1], l1[2], l1[3], h1[0], h1[1], h1[2], h1[3]}, o[d0], 0, 0, 0);   \
        o[d0] = __builtin_amdgcn_mfma_f32_32x32x16_bf16(pa2, (bf16x8){l2[0], l2[1], l2[2], l2[3], h2[0], h2[1], h2[2], h2[3]}, o[d0], 0, 0, 0);   \
        o[d0] = __builtin_amdgcn_mfma_f32_32x32x16_bf16(pa3, (bf16x8){l3[0], l3[1], l3[2], l3[3], h3[0], h3[1], h3[2], h3[3]}, o[d0], 0, 0, 0); } while (0)
    PV_D0(0); PV_D0(1); PV_D0(2); PV_D0(3);
#undef PV_D0
#undef TRRD
}

__device__ __forceinline__ int opaque_hi(int hi) { asm volatile("" : "+v"(hi)); return hi; }
struct BlockRef { const bf16* Q; const bf16* K; const bf16* V; bf16* O; int P0; };
struct Seam { bf16x8 qr[8]; bf16x8 st_v0, st_v1, st_k0, st_k1; };
#define ROW(p, k0, rr) ((p) + (size_t)((k0) + (rr)) * RS + sc)
#define VMW() asm volatile("s_waitcnt vmcnt(0)" ::: "memory")
#define VMWN(n) asm volatile("s_waitcnt vmcnt(%0)" :: "i"(n) : "memory")
#define SLOAD_H(Kp, Vp, k0) do { S.st_v0 = load8(ROW(Vp, k0, sr)); S.st_v1 = load8(ROW(Vp, k0, 32 + sr));              \
                         S.st_k0 = load8(ROW(Kp, k0, sr)); S.st_k1 = load8(ROW(Kp, k0, 32 + sr)); } while (0)
#define SWRITE_HK(bf) do { *(bf16x8*)(K_lds + (bf) * SHM_K + kws) = S.st_k0; *(bf16x8*)(K_lds + (bf) * SHM_K + kws + 32 * 256) = S.st_k1; } while (0)
#define SWRITE_HV(bf) do { *(bf16x8*)(V_lds + (bf) * SHM_V + vst0) = S.st_v0; *(bf16x8*)(V_lds + (bf) * SHM_V + vst0 + 8192) = S.st_v1; } while (0)
#define SWRITE_H(bf) do { SWRITE_HV(bf); SWRITE_HK(bf); } while (0)

__device__ __forceinline__ void prime(const BlockRef& cur, char* lds, Seam& S) {
    const int tid = my_tid(), wid = __builtin_amdgcn_readfirstlane(tid >> 6), lane = tid & 63, r32 = lane & 31, hi = lane >> 5;
    const int sr = tid >> 4, sc = (tid & 15) * 8, kws = KSWZ(sr, sc * 2); char* K_lds = lds + 2 * SHM_V;
#pragma unroll
    for (int d0 = 0; d0 < 8; ++d0) S.qr[d0] = load8(cur.Q + (size_t)(wid * QBLK + r32) * RS + d0 * 16 + hi * 8);
    SLOAD_H(cur.K, cur.V, 0); VMW(); SWRITE_HK(0);
    __syncthreads();
}
__device__ __forceinline__ void block(const BlockRef& cur, const BlockRef& nxt, char* lds, Seam& S, const float* bias_l) {
    const int tid = my_tid(), wid = __builtin_amdgcn_readfirstlane(tid >> 6), lane = tid & 63, r32 = lane & 31, hi = lane >> 5;
    const int NT = (cur.P0 + QB - 1) / KVBLK + 1;
    const int qlo = cur.P0 + wid * QBLK, qm = qlo + r32 - 4 * hi;
    char* V_lds = lds; char* K_lds = lds + 2 * SHM_V;
    float* ws = (float*)(lds + 2 * SHM_V + 2 * SHM_K) + wid * 64; float* li_l = ws, * al_l = ws + 32;
    float m_reg = -1e30f, l_reg = 0; f32x16 o[4] = {};
    const int sr = tid >> 4, sc = (tid & 15) * 8, vst0 = v_st(sr, sc), kws = KSWZ(sr, sc * 2);
    const int vb0 = (int)(uintptr_t)V_lds + v_rd_base(lane);
    const bf16* Kh = cur.K; const bf16* Vh = cur.V;
#define RESC(a) do { if (__any((a) < 1.f)) { if (hi == 0) al_l[r32] = (a); asm volatile("s_waitcnt lgkmcnt(0)" ::: "memory");              \
                     for (int d_ = 0; d_ < 4; ++d_) for (int r = 0; r < 16; ++r) o[d_][r] *= al_l[crow(r, hi)]; } } while (0)
#define KBASE(t) ((t) * KVBLK)
#define BIASP(t) (bias_l + KBASE(t) + 4 * opaque_hi(hi))
#define MASKT(P0_, P1_, t) do { const int kb_ = KBASE(t); if (kb_ + KVBLK - 1 > qlo) mask_tile(P0_, P1_, qm - kb_, (unsigned)W); } while (0)
#define SEAM_K0() do { VMWN(8); SWRITE_HK(0); SBAR(); } while (0)
    f32x16 pA0, pA1, pB0, pB1; float mnA, mnB, alA, alB; bf16x8 pa0, pa1, pa2, pa3;
    SWRITE_HV(0); SBAR();
    if (NT > 1) { SLOAD_H(Kh, Vh, KBASE(1)); }
    SBAR(); qkt<0>(pA0, pA1, K_lds, r32, hi, S.qr, BIASP(0));
    MASKT(pA0, pA1, 0); partialSM(pA0, pA1, m_reg, mnA, alA);
    if (NT > 1) { VMW(); SWRITE_H(1); }
    __syncthreads();
#define HALF_STEP(PX0, PX1, mnX, alX, PY0, PY1, alY, t, KB, VB, SB) do {                                                      \
        SBAR(); qkt<KB>(PX0, PX1, K_lds, r32, hi, S.qr, BIASP(t));                                             \
        finishSM(PY0, PY1, alY, l_reg, pa0, pa1, pa2, pa3); SBAR();                                                           \
        if ((t) + 1 < NT) { SLOAD_H(Kh, Vh, KBASE((t) + 1)); SBAR(); }                                               \
        pv_tile<VB>(o, vb0, pa0, pa1, pa2, pa3); MASKT(PX0, PX1, (t)); partialSM(PX0, PX1, m_reg, mnX, alX);                                        \
        __syncthreads();                                                                                                      \
        if ((t) + 1 < NT) { VMW(); SWRITE_H(SB); }                                                                          \
        RESC(alX); __syncthreads(); } while (0)
    for (int t = 1; t + 1 < NT; t += 2) {
        HALF_STEP(pB0, pB1, mnB, alB, pA0, pA1, alA, t, 1, 0, 0);
        HALF_STEP(pA0, pA1, mnA, alA, pB0, pB1, alB, t + 1, 0, 1, 1);
    }
    const bool even = (NT & 1) == 0;
    if (even) { SBAR(); qkt<1>(pB0, pB1, K_lds, r32, hi, S.qr, BIASP(NT - 1)); SBAR(); }
    SLOAD_H(nxt.K, nxt.V, 0); SBAR();
#pragma unroll
    for (int d0 = 0; d0 < 8; ++d0) S.qr[d0] = load8(nxt.Q + (size_t)(wid * QBLK + r32) * RS + d0 * 16 + hi * 8);
    SBAR();
    finishSM(pA0, pA1, alA, l_reg, pa0, pa1, pa2, pa3); SBAR();
    pv_tile<0>(o, vb0, pa0, pa1, pa2, pa3);
    if (even) { MASKT(pB0, pB1, NT - 1); partialSM(pB0, pB1, m_reg, mnB, alB); __syncthreads(); RESC(alB);
        finishSM(pB0, pB1, alB, l_reg, pa0, pa1, pa2, pa3); SBAR(); pv_tile<1>(o, vb0, pa0, pa1, pa2, pa3); }
    SBAR(); SEAM_K0();
    if (hi == 0) li_l[r32] = l_reg; asm volatile("s_waitcnt lgkmcnt(0)" ::: "memory");
    float rli[16];
#pragma unroll
    for (int r = 0; r < 16; ++r) rli[r] = __builtin_amdgcn_rcpf(li_l[crow(r, hi)]);
    bf16* Ow = cur.O + (size_t)(wid * QBLK) * RS;
#pragma unroll
    for (int r = 0; r < 16; ++r) { const int orow = crow(r, hi);
#pragma unroll
        for (int d0 = 0; d0 < 4; ++d0) { const float v = o[d0][r] * rli[r];
            const float vn = __shfl_xor(v, 1);
            if ((r32 & 1) == 0) *(unsigned*)(Ow + (size_t)orow * RS + d0 * 32 + r32) = cvt_pk_bf16(v, vn); } }
    __syncthreads();
#undef RESC
#undef KBASE
#undef BIASP
#undef MASKT
#undef SEAM_K0
#undef HALF_STEP
}
#undef ROW
#undef VMW
#undef VMWN
#undef SLOAD_H
#undef SWRITE_HK
#undef SWRITE_HV
#undef SWRITE_H

__device__ __forceinline__ void fox_bias(float* bias_l, float* wtot, const float* FG, const float* b_f, int b, int h) {
    const int tid = my_tid(), wid = tid >> 6, lane = tid & 63;
    const float bf = b_f[h];
    float lf[4];
#pragma unroll
    for (int i = 0; i < 4; ++i) { const float z = FG[((size_t)b * SEQ + tid * 4 + i) * 16 + h] + bf; lf[i] = fminf(z, 0.f) - log1pf(__expf(-fabsf(z))); }
    lf[1] += lf[0]; lf[2] += lf[1]; lf[3] += lf[2];
    const float tot = lf[3]; float sc = tot;
#pragma unroll
    for (int off = 1; off < 64; off <<= 1) { const float v = __shfl_up(sc, off); if (lane >= off) sc += v; }
    if (lane == 63) wtot[wid] = sc;
    __syncthreads();
    float basev = 0.f;
    for (int w = 0; w < wid; ++w) basev += wtot[w];
    const float ex = basev + sc - tot;
    const float inv = -1.0f / SCALE;
    f32x4 o4 = {(ex + lf[0]) * inv, (ex + lf[1]) * inv, (ex + lf[2]) * inv, (ex + lf[3]) * inv};
    *(f32x4*)(bias_l + tid * 4) = o4;
    __syncthreads();
}

__device__ __forceinline__ BlockRef mkref(int bh, int qb, const bf16* Q, const bf16* K, const bf16* V, bf16* O) {
    const int b = bh >> 4, h = bh & 15; BlockRef r;
    const size_t kv0 = (size_t)b * SEQ * RS + (size_t)h * D, q0 = kv0 + (size_t)qb * QB * RS;
    r.Q = Q + q0; r.O = O + q0; r.K = K + kv0; r.V = V + kv0; r.P0 = qb * QB; return r;
}
__device__ __forceinline__ void attn_phase(char* lds, const bf16* Q, const bf16* K, const bf16* V, bf16* O, const float* FG, const float* b_f) {
    float* bias_l = (float*)(lds + 131072);
    const int G = my_grid(), total = 512;
    const int bx = my_bid(); const int vid = (G % 8 == 0) ? (bx % 8) * (G / 8) + bx / 8 : bx;
    int L = vid; if (L >= total) return;
    int bh = L >> 2, x = L & 3, pass = 0, slot = 0;
    BlockRef cur = mkref(bh, x, Q, K, V, O);
    fox_bias(bias_l, bias_l + 2 * SEQ, FG, b_f, bh >> 4, bh & 15);
    if (L + G < total) { const int b2 = (L + G) >> 2; fox_bias(bias_l + SEQ, bias_l + 2 * SEQ, FG, b_f, b2 >> 4, b2 & 15); }
    Seam S;
    prime(cur, lds, S);
    for (;;) {
        const bool more_pass = pass == 0, more_item = (L + G < total) && slot == 0, last = !more_pass && !more_item;
        int bhn = bh, xn = x, passn = 1, Ln = L;
        if (!more_pass) { passn = 0; Ln = more_item ? L + G : L; bhn = Ln >> 2; xn = Ln & 3; }
        const BlockRef nxt = last ? cur : mkref(bhn, passn ? 7 - xn : xn, Q, K, V, O);
        block(cur, nxt, lds, S, bias_l + slot * SEQ);
        if (last) break;
        if (!more_pass) slot = 1;
        cur = nxt; bh = bhn; x = xn; pass = passn; L = Ln;
    }
}
}

__device__ __forceinline__ void convT(float* tile, const float* src, int K, int Nsrc, int Ndst, bf16_t* dst, int rot) {
    const int tid = my_tid(), G = my_grid();
    const int ntn = Ndst / 128, ntk = K / 128, ntiles = ntn * ntk;
    for (int ti = (my_bid() + rot) % G; ti < ntiles; ti += G) {
        const int tk = ti / ntn, tn = ti % ntn;
        const int c4 = (tid & 31) * 4, n = tn * 128 + c4;
        f32x4 v[8];
#pragma unroll
        for (int i = 0; i < 8; ++i) { const int k = (tid >> 5) + 16 * i;
            v[i] = (n < Nsrc) ? *(const f32x4*)(src + (size_t)(tk * 128 + k) * Nsrc + n) : (f32x4){0.f, 0.f, 0.f, 0.f}; }
#pragma unroll
        for (int i = 0; i < 8; ++i) { const int k = (tid >> 5) + 16 * i; *(f32x4*)(tile + k * 132 + c4) = v[i]; }
        __syncthreads();
        const int nn = tid & 127, kg0 = tid >> 7;
#pragma unroll
        for (int j = 0; j < 4; ++j) { const int kg = kg0 + 4 * j; const float* tp = tile + (kg * 8) * 132 + nn;
            u32x4 w; w.x = cvt_pk_bf16(tp[0], tp[132]); w.y = cvt_pk_bf16(tp[2 * 132], tp[3 * 132]); w.z = cvt_pk_bf16(tp[4 * 132], tp[5 * 132]); w.w = cvt_pk_bf16(tp[6 * 132], tp[7 * 132]);
            *(u32x4*)(dst + (size_t)(tn * 128 + nn) * K + tk * 128 + kg * 8) = w; }
        __syncthreads();
    }
}
__device__ __forceinline__ void conv_gates(const float* w_a, const float* w_i, bf16_t* dst) {
    const int n = 4096 * 256;
    for (int i = my_bid() * 512 + my_tid(); i < n; i += my_grid() * 512) {
        const int k = i & 255, row = i >> 8, h = row >> 8, gate = (row >> 7) & 1, d = row & 127;
        float v = 0.f;
        if ((k >> 7) == (h & 1)) v = (gate ? w_i : w_a)[((size_t)h * 128 + (k & 127)) * 128 + d];
        dst[i] = (bf16_t)(cvt_pk_bf16(v, 0.f) & 0xffffu);
    }
}

__device__ __forceinline__ void pool_diff(const float* X, bf16_t* DB) {
    const int nitems = NB * 64 * 512;
    for (int item = my_bid() * 512 + my_tid(); item < nitems; item += my_grid() * 512) {
        const int c4 = item & 511, tc = (item >> 9) & 63, b = item >> 15;
        const int win = 2 << (c4 >> 7), t0 = tc * 32;
        const float* xp = X + (size_t)b * SEQ * DM + c4 * 4;
        bf16_t* dp = DB + (size_t)b * SEQ * DM + c4 * 4;
        f32x4 s = {0.f, 0.f, 0.f, 0.f};
        int ts = t0 - win; if (ts < 0) ts = 0;
        for (int t = ts; t < t0; ++t) s += *(const f32x4*)(xp + (size_t)t * DM);
#pragma unroll 8
        for (int t = t0; t < t0 + 32; ++t) {
            const f32x4 v = *(const f32x4*)(xp + (size_t)t * DM);
            f32x4 old = {0.f, 0.f, 0.f, 0.f};
            if (t - win >= 0) old = *(const f32x4*)(xp + (size_t)(t - win) * DM);
            s += v - old;
            const int cnt = (t + 1 < win) ? t + 1 : win;
            const float inv = 1.0f / (float)cnt;
            const f32x4 d = s * inv - v;
            u32x2 w; w.x = cvt_pk_bf16(d[0], d[1]); w.y = cvt_pk_bf16(d[2], d[3]);
            *(u32x2*)(dp + (size_t)t * DM) = w;
        }
    }
}

__device__ __forceinline__ void ln_phase(float* Y, const float* g, const float* bta, bf16_t* XBFp, float* st, bool inplace) {
    const int wid = my_tid() >> 6, lane = my_tid() & 63;
    const int nw = my_grid() * 8;
    for (int row = my_bid() * 8 + wid; row < T; row += 2 * nw) {
        const int row2 = row + nw; const bool has2 = row2 < T;
        float* yp = Y + (size_t)row * DM; float* yp2 = Y + (size_t)(has2 ? row2 : row) * DM;
        f32x4 v[8], v2[8];
#pragma unroll
        for (int i = 0; i < 8; ++i) v[i] = *(const f32x4*)(yp + (i * 64 + lane) * 4);
#pragma unroll
        for (int i = 0; i < 8; ++i) v2[i] = *(const f32x4*)(yp2 + (i * 64 + lane) * 4);
        float s = 0.f, s2 = 0.f;
#pragma unroll
        for (int i = 0; i < 8; ++i) { s += (v[i][0] + v[i][1]) + (v[i][2] + v[i][3]); s2 += (v2[i][0] + v2[i][1]) + (v2[i][2] + v2[i][3]); }
#pragma unroll
        for (int o = 32; o >= 1; o >>= 1) { s += __shfl_xor(s, o); s2 += __shfl_xor(s2, o); }
        const float mean = s * (1.0f / DM), mean2 = s2 * (1.0f / DM);
        float q = 0.f, q2 = 0.f;
#pragma unroll
        for (int i = 0; i < 8; ++i) { const f32x4 d = v[i] - mean, d2 = v2[i] - mean2; q += (d[0] * d[0] + d[1] * d[1]) + (d[2] * d[2] + d[3] * d[3]); q2 += (d2[0] * d2[0] + d2[1] * d2[1]) + (d2[2] * d2[2] + d2[3] * d2[3]); }
#pragma unroll
        for (int o = 32; o >= 1; o >>= 1) { q += __shfl_xor(q, o); q2 += __shfl_xor(q2, o); }
        const float rstd = 1.0f / sqrtf(q * (1.0f / DM) + LN_EPS), rstd2 = 1.0f / sqrtf(q2 * (1.0f / DM) + LN_EPS);
        if (lane == 0) { *(f32x2*)(st + (size_t)row * 2) = (f32x2){mean, rstd}; if (has2) *(f32x2*)(st + (size_t)row2 * 2) = (f32x2){mean2, rstd2}; }
#pragma unroll
        for (int i = 0; i < 8; ++i) { const int c = (i * 64 + lane) * 4;
            const f32x4 gg = *(const f32x4*)(g + c), bb = *(const f32x4*)(bta + c);
            const f32x4 y = (v[i] - mean) * rstd * gg + bb, y2 = (v2[i] - mean2) * rstd2 * gg + bb;
            if (inplace) { *(f32x4*)(yp + c) = y; if (has2) *(f32x4*)(yp2 + c) = y2; }
            u32x2 w; w.x = cvt_pk_bf16(y[0], y[1]); w.y = cvt_pk_bf16(y[2], y[3]);
            *(u32x2*)(XBFp + (size_t)row * DM + c) = w;
            if (has2) { u32x2 w2; w2.x = cvt_pk_bf16(y2[0], y2[1]); w2.y = cvt_pk_bf16(y2[2], y2[3]); *(u32x2*)(XBFp + (size_t)row2 * DM + c) = w2; } }
    }
}

__device__ __forceinline__ void unpack8(const u32x4 w, float* f) {
    f[0] = bf_lo(w.x); f[1] = bf_hi(w.x); f[2] = bf_lo(w.y); f[3] = bf_hi(w.y); f[4] = bf_lo(w.z); f[5] = bf_hi(w.z); f[6] = bf_lo(w.w); f[7] = bf_hi(w.w);
}
__device__ __forceinline__ void convgate_phase(const bf16_t* H, const float* cw, const float* cb, bf16_t* ACT) {
    constexpr int CL = 92, NCH = (SEQ + CL - 1) / CL;
    const int nf8 = FF / 8, nitems = NB * NCH * nf8;
    for (int item = my_bid() * 512 + my_tid(); item < nitems; item += my_grid() * 512) {
        const int f8 = item % nf8, rest = item / nf8, tc = rest % NCH, b = rest / NCH;
        const int f = f8 * 8, t0 = tc * CL, t1 = (t0 + CL < SEQ) ? t0 + CL : SEQ;
        float wg[3][8], wv[3][8], bg[8], bv[8];
#pragma unroll
        for (int k = 0; k < 3; ++k)
#pragma unroll
            for (int h = 0; h < 2; ++h) { const f32x4 a = *(const f32x4*)(cw + (size_t)k * FF2 + f + 4 * h), c = *(const f32x4*)(cw + (size_t)k * FF2 + FF + f + 4 * h);
#pragma unroll
                for (int j = 0; j < 4; ++j) { wg[k][4 * h + j] = a[j]; wv[k][4 * h + j] = c[j]; } }
#pragma unroll
        for (int h = 0; h < 2; ++h) { const f32x4 a = *(const f32x4*)(cb + f + 4 * h), c = *(const f32x4*)(cb + FF + f + 4 * h);
#pragma unroll
            for (int j = 0; j < 4; ++j) { bg[4 * h + j] = a[j]; bv[4 * h + j] = c[j]; } }
        const bf16_t* hp = H + (size_t)b * SEQ * FF2 + f;
        bf16_t* ap = ACT + (size_t)b * SEQ * FF + f;
        float g1[8], g2[8], v1[8], v2[8];
        if (t0 == 0) {
#pragma unroll
            for (int j = 0; j < 8; ++j) { g1[j] = 0.f; g2[j] = 0.f; v1[j] = 0.f; v2[j] = 0.f; }
        } else {
            unpack8(*(const u32x4*)(hp + (size_t)(t0 - 1) * FF2), g1); unpack8(*(const u32x4*)(hp + (size_t)(t0 - 2) * FF2), g2);
            unpack8(*(const u32x4*)(hp + (size_t)(t0 - 1) * FF2 + FF), v1); unpack8(*(const u32x4*)(hp + (size_t)(t0 - 2) * FF2 + FF), v2);
        }
#pragma unroll 4
        for (int t = t0; t < t1; ++t) {
            float g0[8], v0[8];
            unpack8(*(const u32x4*)(hp + (size_t)t * FF2), g0); unpack8(*(const u32x4*)(hp + (size_t)t * FF2 + FF), v0);
            float o[8];
#pragma unroll
            for (int j = 0; j < 8; ++j) {
                const float gg = bg[j] + wg[0][j] * g2[j] + wg[1][j] * g1[j] + wg[2][j] * g0[j];
                const float vv = bv[j] + wv[0][j] * v2[j] + wv[1][j] * v1[j] + wv[2][j] * v0[j];
                o[j] = gg * __builtin_amdgcn_rcpf(1.f + __expf(-gg)) * vv;
                g2[j] = g1[j]; g1[j] = g0[j]; v2[j] = v1[j]; v1[j] = v0[j];
            }
            u32x4 w; w.x = cvt_pk_bf16(o[0], o[1]); w.y = cvt_pk_bf16(o[2], o[3]); w.z = cvt_pk_bf16(o[4], o[5]); w.w = cvt_pk_bf16(o[6], o[7]);
            *(u32x4*)(ap + (size_t)t * FF) = w;
        }
    }
}
__device__ __forceinline__ void conv4_phase(const bf16_t* XBR, const float* cw, const float* cb, bf16_t* XBC) {
    const int nitems = NB * 64 * 256;
    for (int item = my_bid() * 512 + my_tid(); item < nitems; item += my_grid() * 512) {
        const int c8 = item & 255, tc = (item >> 8) & 63, b = item >> 14;
        const int c = c8 * 8, t0 = tc * 32;
        float w[4][8], bb[8];
#pragma unroll
        for (int k = 0; k < 4; ++k)
#pragma unroll
            for (int h = 0; h < 2; ++h) { const f32x4 a = *(const f32x4*)(cw + (size_t)k * DM + c + 4 * h);
#pragma unroll
                for (int j = 0; j < 4; ++j) w[k][4 * h + j] = a[j]; }
#pragma unroll
        for (int h = 0; h < 2; ++h) { const f32x4 a = *(const f32x4*)(cb + c + 4 * h);
#pragma unroll
            for (int j = 0; j < 4; ++j) bb[4 * h + j] = a[j]; }
        const bf16_t* xp = XBR + (size_t)b * SEQ * DM + c;
        bf16_t* op = XBC + (size_t)b * SEQ * DM + c;
        float x1[8], x2[8], x3[8];
        if (t0 == 0) {
#pragma unroll
            for (int j = 0; j < 8; ++j) { x1[j] = 0.f; x2[j] = 0.f; x3[j] = 0.f; }
        } else {
            unpack8(*(const u32x4*)(xp + (size_t)(t0 - 1) * DM), x1); unpack8(*(const u32x4*)(xp + (size_t)(t0 - 2) * DM), x2); unpack8(*(const u32x4*)(xp + (size_t)(t0 - 3) * DM), x3);
        }
#pragma unroll 4
        for (int t = t0; t < t0 + 32; ++t) {
            float x0[8]; unpack8(*(const u32x4*)(xp + (size_t)t * DM), x0);
            float o[8];
#pragma unroll
            for (int j = 0; j < 8; ++j) { o[j] = bb[j] + w[0][j] * x3[j] + w[1][j] * x2[j] + w[2][j] * x1[j] + w[3][j] * x0[j]; x3[j] = x2[j]; x2[j] = x1[j]; x1[j] = x0[j]; }
            u32x4 wv; wv.x = cvt_pk_bf16(o[0], o[1]); wv.y = cvt_pk_bf16(o[2], o[3]); wv.z = cvt_pk_bf16(o[4], o[5]); wv.w = cvt_pk_bf16(o[6], o[7]);
            *(u32x4*)(op + (size_t)t * DM) = wv;
        }
    }
}
__device__ __forceinline__ void scan1_phase(const bf16_t* LA, const bf16_t* BTb, float* CP, float* CH) {
    const int nitems = NB * 32 * 512;
    for (int item = my_bid() * 512 + my_tid(); item < nitems; item += my_grid() * 512) {
        const int c4 = item & 511, ck = (item >> 9) & 31, b = item >> 14;
        const size_t base = ((size_t)b * SEQ + ck * 64) * DM + c4 * 4;
        f32x4 L = {0.f, 0.f, 0.f, 0.f}, Hh = {0.f, 0.f, 0.f, 0.f};
#pragma unroll 8
        for (int t = 0; t < 64; ++t) { const u32x2 lw = *(const u32x2*)(LA + base + (size_t)t * DM), bw = *(const u32x2*)(BTb + base + (size_t)t * DM);
            const f32x4 la = {bf_lo(lw.x), bf_hi(lw.x), bf_lo(lw.y), bf_hi(lw.y)}, bt = {bf_lo(bw.x), bf_hi(bw.x), bf_lo(bw.y), bf_hi(bw.y)};
            f32x4 a; a[0] = __expf(la[0]); a[1] = __expf(la[1]); a[2] = __expf(la[2]); a[3] = __expf(la[3]);
            L += la; Hh = a * Hh + bt; }
        const size_t co = ((size_t)b * 32 + ck) * DM + c4 * 4;
        f32x4 P; P[0] = __expf(L[0]); P[1] = __expf(L[1]); P[2] = __expf(L[2]); P[3] = __expf(L[3]);
        *(f32x4*)(CP + co) = P; *(f32x4*)(CH + co) = Hh;
    }
}
__device__ __forceinline__ void scan2_phase(const bf16_t* LA, const bf16_t* BTb, const float* CP, const float* CH, const bf16_t* GATE, bf16_t* YG) {
    const int nitems = NB * 32 * 512;
    for (int item = my_bid() * 512 + my_tid(); item < nitems; item += my_grid() * 512) {
        const int c4 = item & 511, ck = (item >> 9) & 31, b = item >> 14;
        f32x4 Hh = {0.f, 0.f, 0.f, 0.f};
        for (int j = 0; j < ck; ++j) { const size_t co = ((size_t)b * 32 + j) * DM + c4 * 4; Hh = *(const f32x4*)(CP + co) * Hh + *(const f32x4*)(CH + co); }
        const size_t base = ((size_t)b * SEQ + ck * 64) * DM + c4 * 4;
#pragma unroll 8
        for (int t = 0; t < 64; ++t) { const size_t o = base + (size_t)t * DM;
            const u32x2 lw = *(const u32x2*)(LA + o), bw = *(const u32x2*)(BTb + o); const u32x2 gw = *(const u32x2*)(GATE + o);
            const f32x4 bt = {bf_lo(bw.x), bf_hi(bw.x), bf_lo(bw.y), bf_hi(bw.y)};
            f32x4 a; a[0] = __expf(bf_lo(lw.x)); a[1] = __expf(bf_hi(lw.x)); a[2] = __expf(bf_lo(lw.y)); a[3] = __expf(bf_hi(lw.y));
            Hh = a * Hh + bt;
            u32x2 w; w.x = cvt_pk_bf16(Hh[0] * bf_lo(gw.x), Hh[1] * bf_hi(gw.x)); w.y = cvt_pk_bf16(Hh[2] * bf_lo(gw.y), Hh[3] * bf_hi(gw.y));
            *(u32x2*)(YG + o) = w; }
    }
}

#define XB_TMO      128
#define XB_XCNT(j)  (256  + 64 * (j))
#define XB_XSUB(j)  (1280 + 64 * (j))
#define XB_XGEN(j)  (2304 + 64 * (j))
#define XB_TOP      3328
#define XB_TOPGEN   3392
#define XCD_BAR_WORDS 3456
#define XB_SPIN_CAP (1u << 18)
__device__ __forceinline__ unsigned xb_ld(unsigned* p)              { return __hip_atomic_load(p, __ATOMIC_RELAXED, __HIP_MEMORY_SCOPE_AGENT); }
__device__ __forceinline__ unsigned xb_add(unsigned* p, unsigned v) { return __hip_atomic_fetch_add(p, v, __ATOMIC_RELAXED, __HIP_MEMORY_SCOPE_AGENT); }
__device__ __forceinline__ unsigned xb_xcc_id() { return (unsigned)__builtin_amdgcn_s_getreg((3 << 11) | 20) & 0xFu; }
#define XB_SPIN(cond, bar) do { unsigned _sp = 0; while (cond) { __builtin_amdgcn_s_sleep(1); \
    if ((++_sp & 255u) == 0u) { if (xb_ld(&(bar)[XB_TMO])) break; if (_sp > XB_SPIN_CAP) { atomicAdd(&(bar)[XB_TMO], 1u); break; } } } } while (0)
struct XcdBarrier { unsigned* bar; unsigned x; volatile LAS unsigned* st; };
__device__ __forceinline__ XcdBarrier xcd_barrier_post(unsigned* bar, volatile LAS unsigned* st) {
    XcdBarrier b; b.bar = bar; b.x = xb_xcc_id(); b.st = st;
    if (threadIdx.x == 0) (void)xb_add(&bar[XB_XCNT(b.x)], 1u);
    return b;
}
__device__ __forceinline__ void xcd_barrier_complete(unsigned* bar, unsigned x, unsigned& nloc, unsigned& nx) {
    const unsigned G = gridDim.x * gridDim.y * gridDim.z;
    unsigned sum, cnt, mine, sp = 0u;
    for (;;) {
        sum = 0u; cnt = 0u; mine = 0u;
#pragma unroll
        for (unsigned j = 0; j < 16; ++j) { const unsigned c = xb_ld(&bar[XB_XCNT(j)]); sum += c; cnt += (c > 0u) ? 1u : 0u; mine = (j == x) ? c : mine; }
        if (sum == G) break;
        __builtin_amdgcn_s_sleep(1);
        if ((++sp & 255u) == 0u) { if (xb_ld(&bar[XB_TMO])) break; if (sp > XB_SPIN_CAP) { atomicAdd(&bar[XB_TMO], 1u); break; } }
    }
    nloc = mine > 0u ? mine : 1u; nx = cnt > 0u ? cnt : 1u;
}
__device__ __forceinline__ void xcd_barrier(const XcdBarrier& b) {
    asm volatile("s_waitcnt vmcnt(0)" ::: "memory");
    __syncthreads();
    if (threadIdx.x == 0) {
        unsigned* bar = b.bar;
        __builtin_amdgcn_s_waitcnt(0);
        unsigned nloc = b.st[0], nx = b.st[1];
        if (nloc == 0u) { xcd_barrier_complete(bar, b.x, nloc, nx); b.st[0] = nloc; b.st[1] = nx; }
        const unsigned old = xb_add(&bar[XB_XSUB(b.x)], 1u);
        const unsigned gen = old / nloc;
        if (old + 1u == (gen + 1u) * nloc) {
            __builtin_amdgcn_fence(__ATOMIC_RELEASE, "agent");
            asm volatile("s_waitcnt vmcnt(0)" ::: "memory");
            const unsigned og = xb_add(&bar[XB_TOP], 1u);
            const unsigned tg = og / nx;
            if (og + 1u == (tg + 1u) * nx) xb_add(&bar[XB_TOPGEN], 1u);
            else XB_SPIN(xb_ld(&bar[XB_TOPGEN]) == tg, bar);
            __builtin_amdgcn_fence(__ATOMIC_ACQUIRE, "agent");
            xb_add(&bar[XB_XGEN(b.x)], 1u);
            asm volatile("s_waitcnt vmcnt(0)" ::: "memory");
        } else {
            XB_SPIN(xb_ld(&bar[XB_XGEN(b.x)]) == gen, bar);
            __builtin_amdgcn_fence(__ATOMIC_ACQUIRE, "agent");
            asm volatile("s_waitcnt vmcnt(0)" ::: "memory");
        }
    }
    __syncthreads();
}

struct Params { const float* in[21]; float* out; unsigned char* ws; int ph_lo, ph_hi; };

__global__ void __launch_bounds__(512) mega(Params p) {
    extern __shared__ __attribute__((aligned(16))) unsigned char smem[];
    cg::grid_group grid = cg::this_grid();
    LAS unsigned char* lds = (LAS unsigned char*)smem;
    unsigned char* ws = p.ws;
    const int G = gridDim.x;
    const float* x_in = p.in[0];
    bf16_t* W_UP = (bf16_t*)(ws + WS_WUP); bf16_t* W_DN = (bf16_t*)(ws + WS_WDN); bf16_t* W_POOL = (bf16_t*)(ws + WS_WPOOL);
    bf16_t* W_AIN = (bf16_t*)(ws + WS_WAIN); bf16_t* W_AO = (bf16_t*)(ws + WS_WAO); bf16_t* W_RIN = (bf16_t*)(ws + WS_WRIN);
    bf16_t* W_RG = (bf16_t*)(ws + WS_WRG); bf16_t* W_RO = (bf16_t*)(ws + WS_WRO);
    float* XB = (float*)(ws + WS_XB); bf16_t* XBF = (bf16_t*)(ws + WS_XBF);
    bf16_t* Hb = (bf16_t*)(ws + WS_H); bf16_t* ACTb = (bf16_t*)(ws + WS_ACT);
    float* SPb = (float*)(ws + WS_SP); float* STS = (float*)(ws + WS_ST); float* FG = (float*)(ws + WS_FG); float* CP = (float*)(ws + WS_CP); float* CH = (float*)(ws + WS_CH);
    bf16_t* DB = Hb;
    bf16_t* Qb = Hb; bf16_t* Kb = (bf16_t*)(ws + WS_H + TD2); bf16_t* Vb = (bf16_t*)(ws + WS_H + 2 * TD2); bf16_t* Ob = ACTb;
    bf16_t* XBR = Hb; bf16_t* GATE = (bf16_t*)(ws + WS_H + TD2); bf16_t* XBC = (bf16_t*)(ws + WS_H + 2 * TD2); bf16_t* BTb = (bf16_t*)(ws + WS_H + 3 * TD2);
    bf16_t* LA = (bf16_t*)(ws + WS_ACT); bf16_t* YG = Hb;

    volatile LAS unsigned* xst = (volatile LAS unsigned*)(lds + 131072 + 16384 + 32);
    if (threadIdx.x == 0) { xst[0] = 0u; xst[1] = 0u; }
    __syncthreads();
    XcdBarrier xbar; xbar.bar = (unsigned*)(ws + WS_BAR); xbar.x = 0; xbar.st = xst;
    if (!MK_MULTI) xbar = xcd_barrier_post((unsigned*)(ws + WS_BAR), xst);
    int ph = 0; const int lo = p.ph_lo, hi = p.ph_hi;
    if (hi < 0) grid.sync();
#define RUN(...) do { if (ph >= lo && ph < hi) { __VA_ARGS__; if (ph + 1 < hi) xcd_barrier(xbar); } ++ph; } while (0)

    RUN({
        float* tile = (float*)smem;
        for (int l = 0; l < 4; ++l) convT(tile, p.in[17] + (size_t)l * DM * FF2, DM, FF2, FF2, W_UP + (size_t)l * FF2 * DM, l * 64);
        for (int l = 0; l < 4; ++l) convT(tile, p.in[20] + (size_t)l * FF * DM, FF, DM, DM, W_DN + (size_t)l * DM * FF, l * 64 + 32);
        for (int lg = 0; lg < 8; ++lg) convT(tile, p.in[1] + (size_t)lg * 512 * 512, 512, 512, 512, W_POOL + (size_t)lg * 512 * 512, lg * 16);
        convT(tile, p.in[3], DM, 3 * DM + NH, NQKV, W_AIN, 128);
        convT(tile, p.in[5], DM, DM, DM, W_AO, 160);
        convT(tile, p.in[6], DM, 2 * DM, 2 * DM, W_RIN, 192);
        convT(tile, p.in[14], DM, DM, DM, W_RO, 224);
        conv_gates(p.in[9], p.in[11], W_RG);
        for (int i = my_bid() * 512 + my_tid(); i < DM; i += G * 512) SPb[i] = log1pf(__expf(-p.in[13][i]));
        pool_diff(x_in, DB);
    });

    const float* R = x_in;
    int s = 0;
    for (int layer = 0; layer < 4; ++layer) {
        const int kind = layer % 3;
        pg8::Gemm gm;
        const float* cs = nullptr;
        if (kind == 0) {
            const int j = layer / 3;
            if (layer > 0) RUN({ pool_diff(R, DB); });
            gm = pg8::Gemm{DB, W_POOL + (size_t)j * DM * 512, 512, DM, 512, 2, 512}; cs = p.in[2] + (size_t)j * DM;
        } else if (kind == 1) {
            RUN({ pg8::Gemm g{XBF, W_AIN, DM, DM, DM, 1 << 20, 0}; pg8::StaticOrder S; S.init(T, NQKV, G, my_bid());
                  pg8::EpiGen E{Qb, DM, 1, FG}; pg8::gemm_phase<pg8::EpiGen>(lds, g, S, E); });
            RUN({ att::attn_phase((char*)smem, Qb, Kb, Vb, Ob, FG, p.in[4]); });
            gm = pg8::Gemm{Ob, W_AO, DM, DM, DM, 1 << 20, 0};
        } else {
            RUN({ pg8::Gemm g{XBF, W_RIN, DM, DM, DM, 1 << 20, 0}; pg8::StaticOrder S; S.init(T, 2 * DM, G, my_bid());
                  pg8::EpiGen E{XBR, DM, 2, nullptr}; pg8::gemm_phase<pg8::EpiGen>(lds, g, S, E); });
            RUN({ conv4_phase(XBR, p.in[7], p.in[8], XBC); });
            RUN({ pg8::Gemm g{XBC, W_RG, 256, DM, 256, 2, 256}; pg8::StaticOrder S; S.init(T, 4096, G, my_bid());
                  pg8::EpiGates E{p.in[10], p.in[12], SPb, XBC, LA, BTb}; pg8::gemm_phase<pg8::EpiGates>(lds, g, S, E); });
            RUN({ scan1_phase(LA, BTb, CP, CH); });
            RUN({ scan2_phase(LA, BTb, CP, CH, GATE, YG); });
            gm = pg8::Gemm{YG, W_RO, DM, DM, DM, 1 << 20, 0};
        }
        for (int sub = 0; sub < 2; ++sub) {
            if (sub == 1) {
                RUN({ pg8::Gemm g{XBF, W_UP + (size_t)layer * FF2 * DM, DM, DM, DM, 1 << 20, 0}; pg8::StaticOrder S; S.init(T, FF2, G, my_bid());
                      pg8::EpiGen E{Hb, FF2, 0, nullptr}; pg8::gemm_phase<pg8::EpiGen>(lds, g, S, E); });
                RUN({ convgate_phase(Hb, p.in[18] + (size_t)layer * 3 * FF2, p.in[19] + (size_t)layer * FF2, ACTb); });
                gm = pg8::Gemm{ACTb, W_DN + (size_t)layer * DM * FF, FF, FF, FF, 1 << 20, 0}; cs = nullptr;
            }
            float* Y = (s & 1) ? p.out : XB;
            const bool rawR = (s == 0 || s == 6);
            RUN({ pg8::StaticOrder S; S.init(T, DM, G, my_bid());
                  pg8::EpiRes E{R, Y, cs, rawR ? nullptr : STS, p.in[15] + (size_t)(s > 0 ? s - 1 : 0) * DM, p.in[16] + (size_t)(s > 0 ? s - 1 : 0) * DM};
                  pg8::gemm_phase<pg8::EpiRes>(lds, gm, S, E); });
            RUN({ ln_phase(Y, p.in[15] + (size_t)s * DM, p.in[16] + (size_t)s * DM, XBF, STS, s == 5 || s == 7); });
            R = Y; ++s;
        }
    }
#undef RUN
}

constexpr int N_PHASES = 1 + 6 + 8 + 11 + 7;

extern "C" void kernel_launch(void* const* d_in, const int* in_sizes, int n_in, void* d_out, int out_size, void* d_ws, size_t ws_size, hipStream_t stream) {
    static int grid = 0;
    if (grid == 0) {
        if (n_in != 21 || out_size != T * DM || ws_size < WS_END) { fprintf(stderr, "kernel_launch: unexpected shapes (n_in %d out %d ws %zu)\n", n_in, out_size, ws_size); grid = -1; return; }
        int dev = 0, cus = 0, per_cu = 0;
        (void)hipGetDevice(&dev);
        if (hipDeviceGetAttribute(&cus, hipDeviceAttributeMultiprocessorCount, dev) != hipSuccess || cus <= 0) cus = 256;
        if (hipFuncSetAttribute((const void*)mega, hipFuncAttributeMaxDynamicSharedMemorySize, LDS_BYTES) != hipSuccess) { fprintf(stderr, "kernel_launch: hipFuncSetAttribute failed\n"); grid = -1; return; }
        if (hipOccupancyMaxActiveBlocksPerMultiprocessor(&per_cu, (const void*)mega, 512, LDS_BYTES) != hipSuccess || per_cu < 1) { fprintf(stderr, "kernel_launch: occupancy query says %d\n", per_cu); per_cu = 1; }
        (void)hipGetLastError();
        grid = cus;
    }
    if (grid < 0) return;
    Params p{};
    for (int i = 0; i < 21; ++i) p.in[i] = (const float*)d_in[i];
    p.out = (float*)d_out; p.ws = (unsigned char*)d_ws;
#if MK_MULTI
    for (int k = 0; k < N_PHASES; ++k) { p.ph_lo = k; p.ph_hi = k + 1; hipLaunchKernelGGL(mega, dim3(grid), dim3(512), LDS_BYTES, stream, p); }
#else
    p.ph_lo = 0; p.ph_hi = N_PHASES;
    (void)hipMemsetAsync((char*)d_ws + WS_BAR, 0, XCD_BAR_WORDS * 4, stream);
    void* args[] = {&p};
    hipError_t e = hipLaunchCooperativeKernel((const void*)mega, dim3(grid), dim3(512), args, LDS_BYTES, stream);
    if (e != hipSuccess) fprintf(stderr, "kernel_launch: cooperative launch failed: %s (grid %d)\n", hipGetErrorString(e), grid);
#endif
}
```

```cpp
#include <hip/hip_runtime.h>
#include <hip/hip_bf16.h>
#include <hip/hip_cooperative_groups.h>
#include <cstdio>
#include <cstdint>
namespace cg = cooperative_groups;

#ifndef MK_MULTI
#define MK_MULTI 0
#endif

#define LAS __attribute__((address_space(3)))
typedef unsigned short bf16_t;
typedef short bf16x8 __attribute__((ext_vector_type(8)));
typedef short s16x4 __attribute__((ext_vector_type(4)));
typedef float f32x2 __attribute__((ext_vector_type(2)));
typedef float f32x4 __attribute__((ext_vector_type(4)));
typedef float f32x16 __attribute__((ext_vector_type(16)));
typedef unsigned u32x2 __attribute__((ext_vector_type(2)));
typedef unsigned u32x4 __attribute__((ext_vector_type(4)));

constexpr int NB = 8, SEQ = 2048, DM = 2048, T = NB * SEQ, FF = 5632, FF2 = 2 * FF, NH = 16;
constexpr float LN_EPS = 1e-5f;
constexpr float ALPHA = 1.681792830507429f;
constexpr int NQKV = 6400;

constexpr size_t MiB = 1ull << 20;
constexpr size_t WS_WUP = 0, WUP_L = (size_t)FF2 * DM * 2;
constexpr size_t WS_WDN = 176 * MiB, WDN_L = (size_t)DM * FF * 2;
constexpr size_t WS_WPOOL = 264 * MiB;
constexpr size_t WS_WAIN = 268 * MiB;
constexpr size_t WS_WAO = 293 * MiB;
constexpr size_t WS_WRIN = 301 * MiB;
constexpr size_t WS_WRG = 317 * MiB;
constexpr size_t WS_WRO = 319 * MiB;
constexpr size_t WS_XB = 327 * MiB;
constexpr size_t WS_XBF = 455 * MiB;
constexpr size_t WS_H = 519 * MiB;
constexpr size_t WS_ACT = 871 * MiB;
constexpr size_t WS_FG = 1047 * MiB;
constexpr size_t WS_CP = 1048 * MiB;
constexpr size_t WS_CH = 1050 * MiB;
constexpr size_t WS_SP = 1052 * MiB;
constexpr size_t WS_BAR = 1053 * MiB;
constexpr size_t WS_ST = 1054 * MiB;
constexpr size_t WS_END = 1055 * MiB;
constexpr size_t TD2 = (size_t)T * DM * 2;

constexpr int LDS_BYTES = 131072 + 16384 + 64;

__device__ __forceinline__ int my_tid() { int t = threadIdx.x; asm volatile("" : "+v"(t)); return t; }
__device__ __forceinline__ int my_bid() { int b = blockIdx.x; asm volatile("" : "+s"(b)); return b; }
__device__ __forceinline__ int my_grid() { int g = gridDim.x; asm volatile("" : "+s"(g)); return g; }
__device__ __forceinline__ unsigned cvt_pk_bf16(float lo, float hi) { unsigned r; asm volatile("v_cvt_pk_bf16_f32 %0, %1, %2" : "=v"(r) : "v"(lo), "v"(hi)); return r; }
__device__ __forceinline__ float bf_lo(unsigned u) { return __uint_as_float(u << 16); }
__device__ __forceinline__ float bf_hi(unsigned u) { return __uint_as_float(u & 0xffff0000u); }

namespace pg8 {
constexpr int BM = 256, BK = 64, HALF = 128, HTB = HALF * BK * 2, STAGE_BYTES = 8 * HTB, NXCD = 8, WGM = 8;
__device__ __forceinline__ int lds_byte(int r, int c) { const int st = (r >> 4) * 2 + (c >> 5), rr = r & 15, cc = c & 31, ob = rr * 64 + cc * 2; return st * 1024 + (ob ^ (((ob >> 9) & 1) << 5)); }
__device__ __forceinline__ void stage_rc(int b, int& R, int& C) { const int st = b / 1024, sb = b % 1024, swz = sb ^ (((sb >> 9) & 1) << 5); R = (st >> 1) * 16 + swz / 64; C = (st & 1) * 32 + (swz % 64) / 2; }
__device__ __forceinline__ int perm32(int rho) { const int n = rho >> 4, i = rho & 15; return 8 * (i >> 2) + 4 * n + (i & 3); }

struct Unit { int pm, pn; };
struct Gemm { const bf16_t* A; const bf16_t* Bt; int K, lda, ldb, tpg, a_gs; };

struct StaticOrder {
    int nM, nN, nwg, G, c;
    __device__ void init(int M, int N, int G_, int c_) { nM = M / BM; nN = N / BM; nwg = nM * nN; G = G_; c = c_; }
    __device__ bool next(int i, Unit& u) const {
        const long L = (long)i * G + c; if (L >= nwg) return false;
        int wgid = (int)L; { const int q = nwg / NXCD, r = nwg % NXCD, xcd = wgid % NXCD, off = wgid / NXCD; wgid = (xcd < r ? xcd * (q + 1) : r * (q + 1) + (xcd - r) * q) + off; }
        const int nig = WGM * nN, gid = wgid / nig, fm = gid * WGM, gsz = (nM - fm) < WGM ? (nM - fm) : WGM;
        u.pm = fm + ((wgid % nig) % gsz); u.pn = (wgid % nig) / gsz; return true;
    }
};

template <class Epi>
__device__ __forceinline__ void gemm_phase(LAS unsigned char* lds, const Gemm g, const StaticOrder& S, const Epi& E) {
    const int tid = my_tid(), wid = __builtin_amdgcn_readfirstlane(tid >> 6), lane = tid & 63, wr = wid >> 2, wc = wid & 3, fr = lane & 15, fq = lane >> 4;
    int K = g.K, lda_ = g.lda, ldb_ = g.ldb; asm volatile("" : "+s"(K), "+s"(lda_), "+s"(ldb_));
    const int nt = K / BK;
    unsigned voffA[2], voffB[2];
#pragma unroll
    for (int i = 0; i < 2; ++i) { int R, C; stage_rc(tid * 16 + i * 8192, R, C); const int Rb = Epi::PERM ? ((R & ~31) + perm32(R & 31)) : R;
        voffA[i] = (unsigned)(R * lda_ + C) * 2u; voffB[i] = (unsigned)(Rb * ldb_ + C) * 2u; }
    const size_t kstep = (size_t)(BK * 2);
    const size_t hstepA = (size_t)HALF * lda_ * 2, hstepB = (size_t)HALF * ldb_ * 2;
    const unsigned ldsw = (unsigned)wid * 1024u;
    const int aoff = lds_byte(wr * 64 + fr, fq * 8), boff = lds_byte(wc * 32 + fr, fq * 8);
#define PG8_SA(b, h) (((b) * 2 + (h)) * HTB)
#define PG8_SB(b, h) ((4 + (b) * 2 + (h)) * HTB)
#define PG8_STAGE(bufoff, gbase, voff) do { _Pragma("unroll") for (int _i = 0; _i < 2; ++_i) \
        __builtin_amdgcn_global_load_lds((const unsigned*)((const char*)(gbase) + (voff)[_i]), (LAS unsigned*)(lds + (bufoff) + ldsw + _i * 8192), 16, 0, 0); } while (0)
#define PG8_LDA(dst, b, h) do { _Pragma("unroll") for (int m = 0; m < 4; ++m) _Pragma("unroll") for (int k = 0; k < 2; ++k) dst[m][k] = *(const LAS bf16x8*)(lds + PG8_SA(b, h) + aoff + m * 2048 + k * 1024); } while (0)
#define PG8_LDB(dst, b, h) do { _Pragma("unroll") for (int n = 0; n < 2; ++n) _Pragma("unroll") for (int k = 0; k < 2; ++k) dst[n][k] = *(const LAS bf16x8*)(lds + PG8_SB(b, h) + boff + n * 2048 + k * 1024); } while (0)
#define PG8_MMA(ai, bj, At, Bt) do { __builtin_amdgcn_s_setprio(1); _Pragma("unroll") for (int m = 0; m < 4; ++m) _Pragma("unroll") for (int n = 0; n < 2; ++n) _Pragma("unroll") for (int k = 0; k < 2; ++k) \
        acc[ai][bj][m][n] = __builtin_amdgcn_mfma_f32_16x16x32_bf16(Bt[n][k], At[m][k], acc[ai][bj][m][n], 0, 0, 0); __builtin_amdgcn_s_setprio(0); } while (0)
#define PG8_WAIT_V(n) asm volatile("s_waitcnt vmcnt(" #n ")" ::: "memory")
#define PG8_WAIT_L(n) asm volatile("s_waitcnt lgkmcnt(" #n ")" ::: "memory")
#define PG8_BAR __builtin_amdgcn_s_barrier()
#define PG8_SCHED __builtin_amdgcn_sched_barrier(0)
#define PG8_ABASE(u) ((const char*)g.A + ((size_t)((u).pn / g.tpg) * g.a_gs) * 2 + (size_t)(u).pm * 2 * hstepA)
#define PG8_BBASE(u) ((const char*)g.Bt + (size_t)(u).pn * 2 * hstepB)
    Unit cur, nxt; int ui = 0;
    if (!S.next(0, cur)) return;
    f32x4 acc[2][2][4][2];
#pragma unroll
    for (int a = 0; a < 2; ++a)
#pragma unroll
        for (int b = 0; b < 2; ++b)
#pragma unroll
            for (int m = 0; m < 4; ++m)
#pragma unroll
                for (int n = 0; n < 2; ++n) acc[a][b][m][n] = (f32x4){0.f, 0.f, 0.f, 0.f};
    bf16x8 At[4][2], B0[2][2], B1[2][2];
    const char* cA = PG8_ABASE(cur); const char* cB = PG8_BBASE(cur);
    PG8_STAGE(PG8_SB(0, 0), cB, voffB); PG8_STAGE(PG8_SA(0, 0), cA, voffA); PG8_STAGE(PG8_SB(0, 1), cB + hstepB, voffB); PG8_STAGE(PG8_SA(0, 1), cA + hstepA, voffA);
    if (wr == 1) PG8_BAR;
    PG8_WAIT_V(4); PG8_BAR;
    PG8_STAGE(PG8_SB(1, 0), cB + kstep, voffB); PG8_STAGE(PG8_SA(1, 0), cA + kstep, voffA); PG8_STAGE(PG8_SB(1, 1), cB + hstepB + kstep, voffB);
    PG8_WAIT_V(6); PG8_BAR;
    for (;;) {
        const bool has_next = S.next(ui + 1, nxt);
        const char* nA = has_next ? PG8_ABASE(nxt) : cA; const char* nB = has_next ? PG8_BBASE(nxt) : cB;
        for (int t = 0; t < nt; t += 2) {
            const bool last = (t == nt - 2);
            const char* a1 = cA + (size_t)(t + 1) * kstep;
            const char* a2 = last ? nA : cA + (size_t)(t + 2) * kstep; const char* b2 = last ? nB : cB + (size_t)(t + 2) * kstep;
            const char* a3 = a2 + kstep; const char* b3 = b2 + kstep;
            PG8_LDB(B0, 0, 0); PG8_SCHED; PG8_LDA(At, 0, 0); PG8_STAGE(PG8_SA(1, 1), a1 + hstepA, voffA);
            PG8_WAIT_L(8); PG8_BAR; PG8_WAIT_L(0); PG8_MMA(0, 0, At, B0); PG8_BAR; PG8_SCHED;
            PG8_LDB(B1, 0, 1); PG8_STAGE(PG8_SB(0, 0), b2, voffB);
            PG8_BAR; PG8_WAIT_L(0); PG8_MMA(0, 1, At, B1); PG8_BAR;
            PG8_LDA(At, 0, 1); PG8_STAGE(PG8_SA(0, 0), a2, voffA);
            PG8_BAR; PG8_WAIT_L(0); PG8_MMA(1, 0, At, B0); PG8_BAR; PG8_SCHED;
            PG8_STAGE(PG8_SB(0, 1), b2 + hstepB, voffB);
            PG8_WAIT_V(6); PG8_BAR; PG8_MMA(1, 1, At, B1); PG8_BAR;
            PG8_LDB(B0, 1, 0); PG8_SCHED; PG8_LDA(At, 1, 0); PG8_STAGE(PG8_SA(0, 1), a2 + hstepA, voffA);
            PG8_WAIT_L(8); PG8_BAR; PG8_WAIT_L(0); PG8_MMA(0, 0, At, B0); PG8_BAR; PG8_SCHED;
            PG8_LDB(B1, 1, 1); PG8_STAGE(PG8_SB(1, 0), b3, voffB);
            PG8_BAR; PG8_WAIT_L(0); PG8_MMA(0, 1, At, B1); PG8_BAR;
            PG8_LDA(At, 1, 1); PG8_STAGE(PG8_SA(1, 0), a3, voffA);
            PG8_BAR; PG8_WAIT_L(0); PG8_MMA(1, 0, At, B0); PG8_BAR; PG8_SCHED;
            PG8_STAGE(PG8_SB(1, 1), b3 + hstepB, voffB);
            PG8_WAIT_V(6); PG8_BAR; PG8_MMA(1, 1, At, B1); PG8_BAR;
        }
        E(acc, cur, wr, wc, fr, fq);
        if (!has_next) break;
#pragma unroll
        for (int a = 0; a < 2; ++a)
#pragma unroll
            for (int b = 0; b < 2; ++b)
#pragma unroll
                for (int m = 0; m < 4; ++m)
#pragma unroll
                    for (int n = 0; n < 2; ++n) acc[a][b][m][n] = (f32x4){0.f, 0.f, 0.f, 0.f};
        cur = nxt; cA = nA; cB = nB; ++ui;
    }
    PG8_WAIT_V(0);
    if (wr == 0) PG8_BAR;
    PG8_BAR;
#undef PG8_SA
#undef PG8_SB
#undef PG8_STAGE
#undef PG8_LDA
#undef PG8_LDB
#undef PG8_MMA
#undef PG8_WAIT_V
#undef PG8_WAIT_L
#undef PG8_BAR
#undef PG8_SCHED
#undef PG8_ABASE
#undef PG8_BBASE
}


struct EpiRes {
    static constexpr bool PERM = true;
    const float* R; float* Y; const float* cs; const float* pst; const float* pg; const float* pb;
    __device__ __forceinline__ void operator()(const f32x4 (&acc)[2][2][4][2], const Unit& u, int wr, int wc, int fr, int fq) const {
        asm volatile("" : "+v"(fr), "+v"(fq));
        const int urow = u.pm * BM + wr * 64, ucol = u.pn * BM + wc * 32;
        const unsigned l4 = (unsigned)(fr * DM + 8 * fq) * 4u, ls = (unsigned)fr * 8u, lc = (unsigned)fq * 32u;
#pragma unroll
        for (int ai = 0; ai < 2; ++ai) {
#pragma unroll
            for (int bj = 0; bj < 2; ++bj) { const int cu = ucol + bj * HALF;
                f32x4 g0 = {1.f, 1.f, 1.f, 1.f}, g1 = g0, b0 = {0.f, 0.f, 0.f, 0.f}, b1 = b0, c0 = g0, c1v = g0;
                if (pst) { const char* gp = (const char*)(pg + cu) + lc; const char* bp = (const char*)(pb + cu) + lc;
                    g0 = *(const f32x4*)gp; g1 = *(const f32x4*)(gp + 16); b0 = *(const f32x4*)bp; b1 = *(const f32x4*)(bp + 16); }
                if (cs) { const char* cp = (const char*)(cs + cu) + lc; c0 = *(const f32x4*)cp; c1v = *(const f32x4*)(cp + 16); }
                f32x4 r0[4], r1[4]; f32x2 sv[4];
#pragma unroll
                for (int m = 0; m < 4; ++m) { const size_t uo = (size_t)(urow + ai * HALF + m * 16) * DM + cu;
                    const char* rp = (const char*)(R + uo) + l4; r0[m] = *(const f32x4*)rp; r1[m] = *(const f32x4*)(rp + 16);
                    sv[m] = pst ? *(const f32x2*)((const char*)(pst + (size_t)(urow + ai * HALF + m * 16) * 2) + ls) : (f32x2){0.f, 1.f}; }
#pragma unroll
                for (int m = 0; m < 4; ++m) { const size_t uo = (size_t)(urow + ai * HALF + m * 16) * DM + cu;
                    f32x4 q0 = r0[m], q1 = r1[m];
                    if (pst) { q0 = (q0 - sv[m].x) * sv[m].y * g0 + b0; q1 = (q1 - sv[m].x) * sv[m].y * g1 + b1; }
                    char* yp = (char*)(Y + uo) + l4;
                    *(f32x4*)yp = q0 * ALPHA + acc[ai][bj][m][0] * c0; *(f32x4*)(yp + 16) = q1 * ALPHA + acc[ai][bj][m][1] * c1v; }
                asm volatile("" ::: "memory"); }
        }
    }
};

__device__ __forceinline__ float gelu_tanh(float x) {
    const float u = 0.7978845608028654f * (x + 0.044715f * x * x * x);
    const float e = __expf(2.f * u);
    const float th = 1.f - 2.f * __builtin_amdgcn_rcpf(1.f + e);
    return 0.5f * x * (1.f + th);
}

struct EpiGen {
    static constexpr bool PERM = true;
    bf16_t* O; int ldc; int mode; float* FG;
    __device__ __forceinline__ void operator()(const f32x4 (&acc)[2][2][4][2], const Unit& u, int wr, int wc, int fr, int fq) const {
        asm volatile("" : "+v"(fr), "+v"(fq));
        const int row0 = u.pm * BM + wr * 64 + fr; const int pn = u.pn;
        bf16_t* base = O; int ld = ldc; int colt = pn * BM; bool act = false;
        if (mode == 1) {
            if (pn == 24) {
                if (wc == 0 && fq < 2) {
#pragma unroll
                    for (int ai = 0; ai < 2; ++ai)
#pragma unroll
                        for (int m = 0; m < 4; ++m) { float* p = FG + (size_t)(row0 + ai * HALF + m * 16) * 16 + 8 * fq;
                            *(f32x4*)p = acc[ai][0][m][0]; *(f32x4*)(p + 4) = acc[ai][0][m][1]; }
                }
                return;
            }
            base = O + (size_t)(pn >> 3) * ((size_t)T * DM); colt = (pn & 7) * BM;
        } else if (mode == 2) {
            base = O + (size_t)(pn >> 3) * ((size_t)T * DM); colt = (pn & 7) * BM; act = (pn >= 8);
        }
        const int col0 = colt + wc * 32 + 8 * fq;
#pragma unroll
        for (int ai = 0; ai < 2; ++ai)
#pragma unroll
            for (int m = 0; m < 4; ++m) { bf16_t* rowp = base + (size_t)(row0 + ai * HALF + m * 16) * ld + col0;
#pragma unroll
                for (int bj = 0; bj < 2; ++bj) { f32x4 v0 = acc[ai][bj][m][0], v1 = acc[ai][bj][m][1];
                    if (act) {
#pragma unroll
                        for (int j = 0; j < 4; ++j) { v0[j] = gelu_tanh(v0[j]); v1[j] = gelu_tanh(v1[j]); } }
                    u32x4 w; w.x = cvt_pk_bf16(v0[0], v0[1]); w.y = cvt_pk_bf16(v0[2], v0[3]); w.z = cvt_pk_bf16(v1[0], v1[1]); w.w = cvt_pk_bf16(v1[2], v1[3]);
                    *(u32x4*)(rowp + bj * HALF) = w; } }
    }
};

struct EpiGates {
    static constexpr bool PERM = false;
    const float* b_a; const float* b_i; const float* SP; const bf16_t* XBC; bf16_t* LA; bf16_t* BTb;
    __device__ __forceinline__ void operator()(const f32x4 (&acc)[2][2][4][2], const Unit& u, int wr, int wc, int fr, int fq) const {
        asm volatile("" : "+v"(fr), "+v"(fq));
        const int row0 = u.pm * BM + wr * 64 + fr, ch0 = u.pn * 128 + wc * 32 + 4 * fq;
#pragma unroll
        for (int n = 0; n < 2; ++n) {
            const f32x4 ba = *(const f32x4*)(b_a + ch0 + 16 * n), bi = *(const f32x4*)(b_i + ch0 + 16 * n), sp = *(const f32x4*)(SP + ch0 + 16 * n);
#pragma unroll
            for (int ai = 0; ai < 2; ++ai)
#pragma unroll
                for (int m = 0; m < 4; ++m) { const int t = row0 + ai * HALF + m * 16; const bool first = (t & (SEQ - 1)) == 0;
                    const size_t off = (size_t)t * DM + ch0 + 16 * n;
                    const u32x2 xw = *(const u32x2*)(XBC + off); const float xb[4] = {bf_lo(xw.x), bf_hi(xw.x), bf_lo(xw.y), bf_hi(xw.y)};
                    f32x4 av, bv;
#pragma unroll
                    for (int j = 0; j < 4; ++j) {
                        const float r = __builtin_amdgcn_rcpf(1.f + __expf(-(acc[ai][0][m][n][j] + ba[j])));
                        const float ig = __builtin_amdgcn_rcpf(1.f + __expf(-(acc[ai][1][m][n][j] + bi[j])));
                        const float la = -8.f * r * sp[j];
                        const float a = __expf(la);
                        const float z = 2.f * la;
                        const float ser = -z * (1.f + 0.5f * z * (1.f + (1.f / 3.f) * z * (1.f + 0.25f * z)));
                        const float em = (z > -0.1f) ? ser : (1.f - a * a);
                        const float mult = first ? 1.f : sqrtf(em);
                        av[j] = la; bv[j] = mult * ig * xb[j]; }
                    u32x2 wa, wb; wa.x = cvt_pk_bf16(av[0], av[1]); wa.y = cvt_pk_bf16(av[2], av[3]); wb.x = cvt_pk_bf16(bv[0], bv[1]); wb.y = cvt_pk_bf16(bv[2], bv[3]);
                    *(u32x2*)(LA + off) = wa; *(u32x2*)(BTb + off) = wb;
                    asm volatile("" ::: "memory"); }
        }
    }
};
}

namespace att {
constexpr int D = 128, RS = DM, W = SEQ;
constexpr float SCALE = 0.08838834764831845f, THR = 24.f;
constexpr int NW = 8, QBLK = 32, KVBLK = 64, QB = NW * QBLK;
constexpr int SHM_V = KVBLK * D * 2, SHM_K = KVBLK * D * 2;
constexpr int ATT_LDS = 2 * SHM_V + 2 * SHM_K + NW * 64 * 4;
using bf16 = bf16_t;
#define KSWZ(row, colB) ((row) * 256 + ((colB) ^ (((row) & 7) << 4)))
#define SBAR() __builtin_amdgcn_sched_barrier(0)
__device__ __forceinline__ int v_st(int k, int c) { const int kk = (k & ~0xC) | ((k & 4) << 1) | ((k & 8) >> 1); return ((kk >> 3) * 4 + (c >> 5)) * 512 + ((kk & 7) * 32 + (c & 31)) * 2; }
__device__ __forceinline__ int v_rd_base(int lane) { return ((lane & 3) << 3) | (((lane >> 2) & 3) << 6) | (((lane >> 4) & 1) << 5) | (((lane >> 5) & 1) << 8); }
constexpr int v_rd_off(int d0, int ks, int half) { return d0 * 512 + ks * 4096 + half * 2048; }
__device__ __forceinline__ int crow(int r, int hi) { return (r & 3) + 8 * (r >> 2) + 4 * hi; }
__device__ __forceinline__ bf16x8 load8(const bf16* p) { return *reinterpret_cast<const bf16x8*>(p); }
__device__ __forceinline__ void mask_tile(f32x16& p0, f32x16& p1, int dq, unsigned Wm) {
    const float NEG = -__builtin_inff();
#pragma unroll
    for (int r = 0; r < 16; ++r) {
        const int c = (r & 3) + 8 * (r >> 2);
        if ((unsigned)(dq - c) >= Wm) p0[r] = NEG;
        if ((unsigned)(dq - c - 32) >= Wm) p1[r] = NEG;
    }
}
__device__ __forceinline__ void partialSM(f32x16& p0, f32x16& p1, float& m_reg, float& mn, float& alpha) {
    float pmax = p0[0];
#pragma unroll
    for (int r = 1; r < 16; ++r) pmax = fmaxf(pmax, p0[r]);
#pragma unroll
    for (int r = 0; r < 16; ++r) pmax = fmaxf(pmax, p1[r]);
    { auto rr = __builtin_amdgcn_permlane32_swap(__float_as_uint(pmax), __float_as_uint(pmax), false, false);
      pmax = fmaxf(__uint_as_float(rr[0]), __uint_as_float(rr[1])); }
    constexpr float C2 = 1.4426950408889634f * SCALE;
    if (__builtin_expect(__all((pmax - m_reg) * SCALE <= THR), 1)) { mn = m_reg; alpha = 1.f; }
    else { mn = fmaxf(m_reg, pmax); alpha = __builtin_amdgcn_exp2f((m_reg - mn) * C2); m_reg = mn; }
    const float mnL = -mn * C2;
#pragma unroll
    for (int r = 0; r < 16; ++r) p0[r] = fmaf(p0[r], C2, mnL);
#pragma unroll
    for (int r = 0; r < 16; ++r) p1[r] = fmaf(p1[r], C2, mnL);
#pragma unroll
    for (int r = 0; r < 16; ++r) p0[r] = __builtin_amdgcn_exp2f(p0[r]);
}
__device__ __forceinline__ void finishSM(f32x16& p0, f32x16& p1, float alpha, float& l_reg, bf16x8& pa0, bf16x8& pa1, bf16x8& pa2, bf16x8& pa3) {
#pragma unroll
    for (int r = 0; r < 16; ++r) p1[r] = __builtin_amdgcn_exp2f(p1[r]);
    float ps = 0;
#pragma unroll
    for (int r = 0; r < 16; ++r) ps += p0[r];
#pragma unroll
    for (int r = 0; r < 16; ++r) ps += p1[r];
    { auto rr = __builtin_amdgcn_permlane32_swap(__float_as_uint(ps), __float_as_uint(ps), false, false);
      ps = __uint_as_float(rr[0]) + __uint_as_float(rr[1]); }
    l_reg = l_reg * alpha + ps;
#define PK4(P, B_, OUT) do { unsigned a0 = cvt_pk_bf16(P[B_+0], P[B_+1]), a1 = cvt_pk_bf16(P[B_+2], P[B_+3]);                          \
        unsigned b0 = cvt_pk_bf16(P[B_+4], P[B_+5]), b1 = cvt_pk_bf16(P[B_+6], P[B_+7]);                                             \
        auto r0 = __builtin_amdgcn_permlane32_swap(a0, b0, false, false); auto r1 = __builtin_amdgcn_permlane32_swap(a1, b1, false, false); \
        u32x4 w = {r0[0], r1[0], r0[1], r1[1]}; OUT = *reinterpret_cast<bf16x8*>(&w); } while (0)
    PK4(p0, 0, pa0); PK4(p0, 8, pa1); PK4(p1, 0, pa2); PK4(p1, 8, pa3);
#undef PK4
}
template <int KB>
__device__ __forceinline__ void qkt(f32x16& p0, f32x16& p1, const char* K_lds, int r32, int hi, const bf16x8* qr, const float* bt) {
#pragma unroll
    for (int g = 0; g < 4; ++g) { const f32x4 x0 = *(const f32x4*)(bt + 8 * g), x1 = *(const f32x4*)(bt + 32 + 8 * g);
#pragma unroll
        for (int j = 0; j < 4; ++j) { p0[4 * g + j] = x0[j]; p1[4 * g + j] = x1[j]; } }
    const char* kb[4];
#pragma unroll
    for (int dd = 0; dd < 4; ++dd) kb[dd] = K_lds + KB * SHM_K + KSWZ(r32, (dd * 16 + hi * 8) * 2);
#pragma unroll
    for (int d0 = 0; d0 < 8; ++d0) { const char* a = kb[d0 & 3] + (d0 >> 2) * 128;
        bf16x8 b0 = *reinterpret_cast<const bf16x8*>(a);
        bf16x8 b1 = *reinterpret_cast<const bf16x8*>(a + 32 * 256);
        p0 = __builtin_amdgcn_mfma_f32_32x32x16_bf16(b0, qr[d0], p0, 0, 0, 0);
        p1 = __builtin_amdgcn_mfma_f32_32x32x16_bf16(b1, qr[d0], p1, 0, 0, 0); }
}
template <int VB>
__device__ __forceinline__ void pv_tile(f32x16* o, int vb0, bf16x8 pa0, bf16x8 pa1, bf16x8 pa2, bf16x8 pa3) {
#define TRRD(dst, off) asm volatile("ds_read_b64_tr_b16 %0, %1 offset:%2" : "=&v"(dst) : "v"(vb0), "i"(off) : "memory")
#define PV_D0(d0) do { s16x4 l0, l1, l2, l3, h0, h1, h2, h3; constexpr int b_ = VB * SHM_V + v_rd_off(d0, 0, 0); \
        TRRD(l0, b_); TRRD(h0, b_ + 2048); TRRD(l1, b_ + 4096); TRRD(h1, b_ + 6144); TRRD(l2, b_ + 8192); TRRD(h2, b_ + 10240); TRRD(l3, b_ + 12288); TRRD(h3, b_ + 14336); \
        asm volatile("s_waitcnt lgkmcnt(0)" ::: "memory"); SBAR();   \
        o[d0] = __builtin_amdgcn_mfma_f32_32x32x16_bf16(pa0, (bf16x8){l0[0], l0[1], l0[2], l0[3], h0[0], h0[1], h0[2], h0[3]}, o[d0], 0, 0, 0);   \
        o[d0] = __builtin_amdgcn_mfma_f32_32x32x16_bf16(pa1, (bf16x8){l1[0], l1[1], l1[2], l1[3], h1[0], h1[1], h1[2], h1[3]}, o[d0], 0, 0, 0);   \
        o[d0] = __builtin_amdgcn_mfma_f32_32x32x16_bf16(pa2, (bf16x8){l2[0], l2[1], l2[2], l2[3], h2[0], h2[1], h2[2], h2[3]}, o[d0], 0, 0, 0);   \
        o[d0] = __builtin_amdgcn_mfma_f32_32x32x16_bf16(pa3, (bf16x8){l3[0], l3[1], l3[2], l3[3], h3[0], h3[1], h3[2], h3[3]}, o[d0], 0, 0, 0); } while (0)
    PV_D0(0); PV_D0(1); PV_D0(2); PV_D0(3);
#undef PV_D0
#undef TRRD
}

__device__ __forceinline__ int opaque_hi(int hi) { asm volatile("" : "+v"(hi)); return hi; }
struct BlockRef { const bf16* Q; const bf16* K; const bf16* V; bf16* O; int P0; };
struct Seam { bf16x8 qr[8]; bf16x8 st_v0, st_v1, st_k0, st_k1; };
#define ROW(p, k0, rr) ((p) + (size_t)((k0) + (rr)) * RS + sc)
#define VMW() asm volatile("s_waitcnt vmcnt(0)" ::: "memory")
#define VMWN(n) asm volatile("s_waitcnt vmcnt(%0)" :: "i"(n) : "memory")
#define SLOAD_H(Kp, Vp, k0) do { S.st_v0 = load8(ROW(Vp, k0, sr)); S.st_v1 = load8(ROW(Vp, k0, 32 + sr));              \
                         S.st_k0 = load8(ROW(Kp, k0, sr)); S.st_k1 = load8(ROW(Kp, k0, 32 + sr)); } while (0)
#define SWRITE_HK(bf) do { *(bf16x8*)(K_lds + (bf) * SHM_K + kws) = S.st_k0; *(bf16x8*)(K_lds + (bf) * SHM_K + kws + 32 * 256) = S.st_k1; } while (0)
#define SWRITE_HV(bf) do { *(bf16x8*)(V_lds + (bf) * SHM_V + vst0) = S.st_v0; *(bf16x8*)(V_lds + (bf) * SHM_V + vst0 + 8192) = S.st_v1; } while (0)
#define SWRITE_H(bf) do { SWRITE_HV(bf); SWRITE_HK(bf); } while (0)

__device__ __forceinline__ void prime(const BlockRef& cur, char* lds, Seam& S) {
    const int tid = my_tid(), wid = __builtin_amdgcn_readfirstlane(tid >> 6), lane = tid & 63, r32 = lane & 31, hi = lane >> 5;
    const int sr = tid >> 4, sc = (tid & 15) * 8, kws = KSWZ(sr, sc * 2); char* K_lds = lds + 2 * SHM_V;
#pragma unroll
    for (int d0 = 0; d0 < 8; ++d0) S.qr[d0] = load8(cur.Q + (size_t)(wid * QBLK + r32) * RS + d0 * 16 + hi * 8);
    SLOAD_H(cur.K, cur.V, 0); VMW(); SWRITE_HK(0);
    __syncthreads();
}
__device__ __forceinline__ void block(const BlockRef& cur, const BlockRef& nxt, char* lds, Seam& S, const float* bias_l) {
    const int tid = my_tid(), wid = __builtin_amdgcn_readfirstlane(tid >> 6), lane = tid & 63, r32 = lane & 31, hi = lane >> 5;
    const int NT = (cur.P0 + QB - 1) / KVBLK + 1;
    const int qlo = cur.P0 + wid * QBLK, qm = qlo + r32 - 4 * hi;
    char* V_lds = lds; char* K_lds = lds + 2 * SHM_V;
    float* ws = (float*)(lds + 2 * SHM_V + 2 * SHM_K) + wid * 64; float* li_l = ws, * al_l = ws + 32;
    float m_reg = -1e30f, l_reg = 0; f32x16 o[4] = {};
    const int sr = tid >> 4, sc = (tid & 15) * 8, vst0 = v_st(sr, sc), kws = KSWZ(sr, sc * 2);
    const int vb0 = (int)(uintptr_t)V_lds + v_rd_base(lane);
    const bf16* Kh = cur.K; const bf16* Vh = cur.V;
#define RESC(a) do { if (__any((a) < 1.f)) { if (hi == 0) al_l[r32] = (a); asm volatile("s_waitcnt lgkmcnt(0)" ::: "memory");              \
                     for (int d_ = 0; d_ < 4; ++d_) for (int r = 0; r < 16; ++r) o[d_][r] *= al_l[crow(r, hi)]; } } while (0)
#define KBASE(t) ((t) * KVBLK)
#define BIASP(t) (bias_l + KBASE(t) + 4 * opaque_hi(hi))
#define MASKT(P0_, P1_, t) do { const int kb_ = KBASE(t); if (kb_ + KVBLK - 1 > qlo) mask_tile(P0_, P1_, qm - kb_, (unsigned)W); } while (0)
#define SEAM_K0() do { VMWN(8); SWRITE_HK(0); SBAR(); } while (0)
    f32x16 pA0, pA1, pB0, pB1; float mnA, mnB, alA, alB; bf16x8 pa0, pa1, pa2, pa3;
    SWRITE_HV(0); SBAR();
    if (NT > 1) { SLOAD_H(Kh, Vh, KBASE(1)); }
    SBAR(); qkt<0>(pA0, pA1, K_lds, r32, hi, S.qr, BIASP(0));
    MASKT(pA0, pA1, 0); partialSM(pA0, pA1, m_reg, mnA, alA);
    if (NT > 1) { VMW(); SWRITE_H(1); }
    __syncthreads();
#define HALF_STEP(PX0, PX1, mnX, alX, PY0, PY1, alY, t, KB, VB, SB) do {                                                      \
        SBAR(); qkt<KB>(PX0, PX1, K_lds, r32, hi, S.qr, BIASP(t));                                             \
        finishSM(PY0, PY1, alY, l_reg, pa0, pa1, pa2, pa3); SBAR();                                                           \
        if ((t) + 1 < NT) { SLOAD_H(Kh, Vh, KBASE((t) + 1)); SBAR(); }                                               \
        pv_tile<VB>(o, vb0, pa0, pa1, pa2, pa3); MASKT(PX0, PX1, (t)); partialSM(PX0, PX1, m_reg, mnX, alX);                                        \
        __syncthreads();                                                                                                      \
        if ((t) + 1 < NT) { VMW(); SWRITE_H(SB); }                                                                          \
        RESC(alX); __syncthreads(); } while (0)
    for (int t = 1; t + 1 < NT; t += 2) {
        HALF_STEP(pB0, pB1, mnB, alB, pA0, pA1, alA, t, 1, 0, 0);
        HALF_STEP(pA0, pA1, mnA, alA, pB0, pB1, alB, t + 1, 0, 1, 1);
    }
    const bool even = (NT & 1) == 0;
    if (even) { SBAR(); qkt<1>(pB0, pB1, K_lds, r32, hi, S.qr, BIASP(NT - 1)); SBAR(); }
    SLOAD_H(nxt.K, nxt.V, 0); SBAR();
#pragma unroll
    for (int d0 = 0; d0 < 8; ++d0) S.qr[d0] = load8(nxt.Q + (size_t)(wid * QBLK + r32) * RS + d0 * 16 + hi * 8);
    SBAR();
    finishSM(pA0, pA1, alA, l_reg, pa0, pa1, pa2, pa3); SBAR();
    pv_tile<0>(o, vb0, pa0, pa1, pa2, pa3);
    if (even) { MASKT(pB0, pB1, NT - 1); partialSM(pB0, pB1, m_reg, mnB, alB); __syncthreads(); RESC(alB);
        finishSM(pB0, pB1, alB, l_reg, pa0, pa1, pa2, pa3); SBAR(); pv_tile<1>(o, vb0, pa0, pa1, pa2, pa3); }
    SBAR(); SEAM_K0();
    if (hi == 0) li_l[r32] = l_reg; asm volatile("s_waitcnt lgkmcnt(0)" ::: "memory");
    float rli[16];
#pragma unroll
    for (int r = 0; r < 16; ++r) rli[r] = __builtin_amdgcn_rcpf(li_l[crow(r, hi)]);
    bf16* Ow = cur.O + (size_t)(wid * QBLK) * RS;
#pragma unroll
    for (int r = 0; r < 16; ++r) { const int orow = crow(r, hi);
#pragma unroll
        for (int d0 = 0; d0 < 4; ++d0) { const float v = o[d0][r] * rli[r];
            const float vn = __shfl_xor(v, 1);
            if ((r32 & 1) == 0) *(unsigned*)(Ow + (size_t)orow * RS + d0 * 32 + r32) = cvt_pk_bf16(v, vn); } }
    __syncthreads();
#undef RESC
#undef KBASE
#undef BIASP
#undef MASKT
#undef SEAM_K0
#undef HALF_STEP
}
#undef ROW
#undef VMW
#undef VMWN
#undef SLOAD_H
#undef SWRITE_HK
#undef SWRITE_HV
#undef SWRITE_H

__device__ __forceinline__ void fox_bias(float* bias_l, float* wtot, const float* FG, const float* b_f, int b, int h) {
    const int tid = my_tid(), wid = tid >> 6, lane = tid & 63;
    const float bf = b_f[h];
    float lf[4];
#pragma unroll
    for (int i = 0; i < 4; ++i) { const float z = FG[((size_t)b * SEQ + tid * 4 + i) * 16 + h] + bf; lf[i] = fminf(z, 0.f) - log1pf(__expf(-fabsf(z))); }
    lf[1] += lf[0]; lf[2] += lf[1]; lf[3] += lf[2];
    const float tot = lf[3]; float sc = tot;
#pragma unroll
    for (int off = 1; off < 64; off <<= 1) { const float v = __shfl_up(sc, off); if (lane >= off) sc += v; }
    if (lane == 63) wtot[wid] = sc;
    __syncthreads();
    float basev = 0.f;
    for (int w = 0; w < wid; ++w) basev += wtot[w];
    const float ex = basev + sc - tot;
    const float inv = -1.0f / SCALE;
    f32x4 o4 = {(ex + lf[0]) * inv, (ex + lf[1]) * inv, (ex + lf[2]) * inv, (ex + lf[3]) * inv};
    *(f32x4*)(bias_l + tid * 4) = o4;
    __syncthreads();
}

__device__ __forceinline__ BlockRef mkref(int bh, int qb, const bf16* Q, const bf16* K, const bf16* V, bf16* O) {
    const int b = bh >> 4, h = bh & 15; BlockRef r;
    const size_t kv0 = (size_t)b * SEQ * RS + (size_t)h * D, q0 = kv0 + (size_t)qb * QB * RS;
    r.Q = Q + q0; r.O = O + q0; r.K = K + kv0; r.V = V + kv0; r.P0 = qb * QB; return r;
}
__device__ __forceinline__ void attn_phase(char* lds, const bf16* Q, const bf16* K, const bf16* V, bf16* O, const float* FG, const float* b_f) {
    float* bias_l = (float*)(lds + 131072);
    const int G = my_grid(), total = 512;
    const int bx = my_bid(); const int vid = (G % 8 == 0) ? (bx % 8) * (G / 8) + bx / 8 : bx;
    int L = vid; if (L >= total) return;
    int bh = L >> 2, x = L & 3, pass = 0, slot = 0;
    BlockRef cur = mkref(bh, x, Q, K, V, O);
    fox_bias(bias_l, bias_l + 2 * SEQ, FG, b_f, bh >> 4, bh & 15);
    if (L + G < total) { const int b2 = (L + G) >> 2; fox_bias(bias_l + SEQ, bias_l + 2 * SEQ, FG, b_f, b2 >> 4, b2 & 15); }
    Seam S;
    prime(cur, lds, S);
    for (;;) {
        const bool more_pass = pass == 0, more_item = (L + G < total) && slot == 0, last = !more_pass && !more_item;
        int bhn = bh, xn = x, passn = 1, Ln = L;
        if (!more_pass) { passn = 0; Ln = more_item ? L + G : L; bhn = Ln >> 2; xn = Ln & 3; }
        const BlockRef nxt = last ? cur : mkref(bhn, passn ? 7 - xn : xn, Q, K, V, O);
        block(cur, nxt, lds, S, bias_l + slot * SEQ);
        if (last) break;
        if (!more_pass) slot = 1;
        cur = nxt; bh = bhn; x = xn; pass = passn; L = Ln;
    }
}
}

__device__ __forceinline__ void convT(float* tile, const float* src, int K, int Nsrc, int Ndst, bf16_t* dst, int rot) {
    const int tid = my_tid(), G = my_grid();
    const int ntn = Ndst / 128, ntk = K / 128, ntiles = ntn * ntk;
    const int c4 = (tid & 31) * 4, kr = tid >> 5;
    int ti = (my_bid() + rot) % G;
    f32x4 v[8];
#define CT_LOAD(t_) do { const int tk_ = (t_) / ntn, tn_ = (t_) % ntn; const int n_ = tn_ * 128 + c4; \
        _Pragma("unroll") for (int i = 0; i < 8; ++i) v[i] = (n_ < Nsrc) ? *(const f32x4*)(src + (size_t)(tk_ * 128 + kr + 16 * i) * Nsrc + n_) : (f32x4){0.f, 0.f, 0.f, 0.f}; } while (0)
    if (ti < ntiles) CT_LOAD(ti);
    for (; ti < ntiles; ti += G) {
        const int tk = ti / ntn, tn = ti % ntn;
#pragma unroll
        for (int i = 0; i < 8; ++i) *(f32x4*)(tile + (kr + 16 * i) * 132 + c4) = v[i];
        __syncthreads();
        if (ti + G < ntiles) CT_LOAD(ti + G);
        const int nn = tid & 127, kg0 = tid >> 7;
#pragma unroll
        for (int j = 0; j < 4; ++j) { const int kg = kg0 + 4 * j; const float* tp = tile + (kg * 8) * 132 + nn;
            u32x4 w; w.x = cvt_pk_bf16(tp[0], tp[132]); w.y = cvt_pk_bf16(tp[2 * 132], tp[3 * 132]); w.z = cvt_pk_bf16(tp[4 * 132], tp[5 * 132]); w.w = cvt_pk_bf16(tp[6 * 132], tp[7 * 132]);
            *(u32x4*)(dst + (size_t)(tn * 128 + nn) * K + tk * 128 + kg * 8) = w; }
        __syncthreads();
    }
#undef CT_LOAD
}
__device__ __forceinline__ void conv_gates(const float* w_a, const float* w_i, bf16_t* dst) {
    const int n = 4096 * 256;
    for (int i = my_bid() * 512 + my_tid(); i < n; i += my_grid() * 512) {
        const int k = i & 255, row = i >> 8, h = row >> 8, gate = (row >> 7) & 1, d = row & 127;
        float v = 0.f;
        if ((k >> 7) == (h & 1)) v = (gate ? w_i : w_a)[((size_t)h * 128 + (k & 127)) * 128 + d];
        dst[i] = (bf16_t)(cvt_pk_bf16(v, 0.f) & 0xffffu);
    }
}

__device__ __forceinline__ void pool_diff(const float* X, bf16_t* DB) {
    const int nitems = NB * 64 * 512;
    for (int item = my_bid() * 512 + my_tid(); item < nitems; item += my_grid() * 512) {
        const int c4 = item & 511, tc = (item >> 9) & 63, b = item >> 15;
        const int win = 2 << (c4 >> 7), t0 = tc * 32;
        const float* xp = X + (size_t)b * SEQ * DM + c4 * 4;
        bf16_t* dp = DB + (size_t)b * SEQ * DM + c4 * 4;
        f32x4 s = {0.f, 0.f, 0.f, 0.f};
        int ts = t0 - win; if (ts < 0) ts = 0;
        for (int t = ts; t < t0; ++t) s += *(const f32x4*)(xp + (size_t)t * DM);
#pragma unroll 8
        for (int t = t0; t < t0 + 32; ++t) {
            const f32x4 v = *(const f32x4*)(xp + (size_t)t * DM);
            f32x4 old = {0.f, 0.f, 0.f, 0.f};
            if (t - win >= 0) old = *(const f32x4*)(xp + (size_t)(t - win) * DM);
            s += v - old;
            const int cnt = (t + 1 < win) ? t + 1 : win;
            const float inv = 1.0f / (float)cnt;
            const f32x4 d = s * inv - v;
            u32x2 w; w.x = cvt_pk_bf16(d[0], d[1]); w.y = cvt_pk_bf16(d[2], d[3]);
            *(u32x2*)(dp + (size_t)t * DM) = w;
        }
    }
}

__device__ __forceinline__ void ln_phase(float* Y, const float* g, const float* bta, bf16_t* XBFp, float* st, bool inplace) {
    const int wid = my_tid() >> 6, lane = my_tid() & 63;
    const int nw = my_grid() * 8;
    for (int row = my_bid() * 8 + wid; row < T; row += 2 * nw) {
        const int row2 = row + nw; const bool has2 = row2 < T;
        float* yp = Y + (size_t)row * DM; float* yp2 = Y + (size_t)(has2 ? row2 : row) * DM;
        f32x4 v[8], v2[8];
#pragma unroll
        for (int i = 0; i < 8; ++i) v[i] = *(const f32x4*)(yp + (i * 64 + lane) * 4);
#pragma unroll
        for (int i = 0; i < 8; ++i) v2[i] = *(const f32x4*)(yp2 + (i * 64 + lane) * 4);
        float s = 0.f, s2 = 0.f;
#pragma unroll
        for (int i = 0; i < 8; ++i) { s += (v[i][0] + v[i][1]) + (v[i][2] + v[i][3]); s2 += (v2[i][0] + v2[i][1]) + (v2[i][2] + v2[i][3]); }
#pragma unroll
        for (int o = 32; o >= 1; o >>= 1) { s += __shfl_xor(s, o); s2 += __shfl_xor(s2, o); }
        const float mean = s * (1.0f / DM), mean2 = s2 * (1.0f / DM);
        float q = 0.f, q2 = 0.f;
#pragma unroll
        for (int i = 0; i < 8; ++i) { const f32x4 d = v[i] - mean, d2 = v2[i] - mean2; q += (d[0] * d[0] + d[1] * d[1]) + (d[2] * d[2] + d[3] * d[3]); q2 += (d2[0] * d2[0] + d2[1] * d2[1]) + (d2[2] * d2[2] + d2[3] * d2[3]); }
#pragma unroll
        for (int o = 32; o >= 1; o >>= 1) { q += __shfl_xor(q, o); q2 += __shfl_xor(q2, o); }
        const float rstd = 1.0f / sqrtf(q * (1.0f / DM) + LN_EPS), rstd2 = 1.0f / sqrtf(q2 * (1.0f / DM) + LN_EPS);
        if (lane == 0) { *(f32x2*)(st + (size_t)row * 2) = (f32x2){mean, rstd}; if (has2) *(f32x2*)(st + (size_t)row2 * 2) = (f32x2){mean2, rstd2}; }
#pragma unroll
        for (int i = 0; i < 8; ++i) { const int c = (i * 64 + lane) * 4;
            const f32x4 gg = *(const f32x4*)(g + c), bb = *(const f32x4*)(bta + c);
            const f32x4 y = (v[i] - mean) * rstd * gg + bb, y2 = (v2[i] - mean2) * rstd2 * gg + bb;
            if (inplace) { *(f32x4*)(yp + c) = y; if (has2) *(f32x4*)(yp2 + c) = y2; }
            u32x2 w; w.x = cvt_pk_bf16(y[0], y[1]); w.y = cvt_pk_bf16(y[2], y[3]);
            *(u32x2*)(XBFp + (size_t)row * DM + c) = w;
            if (has2) { u32x2 w2; w2.x = cvt_pk_bf16(y2[0], y2[1]); w2.y = cvt_pk_bf16(y2[2], y2[3]); *(u32x2*)(XBFp + (size_t)row2 * DM + c) = w2; } }
    }
}

__device__ __forceinline__ void unpack8(const u32x4 w, float* f) {
    f[0] = bf_lo(w.x); f[1] = bf_hi(w.x); f[2] = bf_lo(w.y); f[3] = bf_hi(w.y); f[4] = bf_lo(w.z); f[5] = bf_hi(w.z); f[6] = bf_lo(w.w); f[7] = bf_hi(w.w);
}
__device__ __forceinline__ void convgate_phase(const bf16_t* H, const float* cw, const float* cb, bf16_t* ACT) {
    constexpr int CL = 92, NCH = (SEQ + CL - 1) / CL;
    const int nf8 = FF / 8, nitems = NB * NCH * nf8;
    for (int item = my_bid() * 512 + my_tid(); item < nitems; item += my_grid() * 512) {
        const int f8 = item % nf8, rest = item / nf8, tc = rest % NCH, b = rest / NCH;
        const int f = f8 * 8, t0 = tc * CL, t1 = (t0 + CL < SEQ) ? t0 + CL : SEQ;
        float wg[3][8], wv[3][8], bg[8], bv[8];
#pragma unroll
        for (int k = 0; k < 3; ++k)
#pragma unroll
            for (int h = 0; h < 2; ++h) { const f32x4 a = *(const f32x4*)(cw + (size_t)k * FF2 + f + 4 * h), c = *(const f32x4*)(cw + (size_t)k * FF2 + FF + f + 4 * h);
#pragma unroll
                for (int j = 0; j < 4; ++j) { wg[k][4 * h + j] = a[j]; wv[k][4 * h + j] = c[j]; } }
#pragma unroll
        for (int h = 0; h < 2; ++h) { const f32x4 a = *(const f32x4*)(cb + f + 4 * h), c = *(const f32x4*)(cb + FF + f + 4 * h);
#pragma unroll
            for (int j = 0; j < 4; ++j) { bg[4 * h + j] = a[j]; bv[4 * h + j] = c[j]; } }
        const bf16_t* hp = H + (size_t)b * SEQ * FF2 + f;
        bf16_t* ap = ACT + (size_t)b * SEQ * FF + f;
        float g1[8], g2[8], v1[8], v2[8];
        if (t0 == 0) {
#pragma unroll
            for (int j = 0; j < 8; ++j) { g1[j] = 0.f; g2[j] = 0.f; v1[j] = 0.f; v2[j] = 0.f; }
        } else {
            unpack8(*(const u32x4*)(hp + (size_t)(t0 - 1) * FF2), g1); unpack8(*(const u32x4*)(hp + (size_t)(t0 - 2) * FF2), g2);
            unpack8(*(const u32x4*)(hp + (size_t)(t0 - 1) * FF2 + FF), v1); unpack8(*(const u32x4*)(hp + (size_t)(t0 - 2) * FF2 + FF), v2);
        }
#pragma unroll 4
        for (int t = t0; t < t1; ++t) {
            float g0[8], v0[8];
            unpack8(*(const u32x4*)(hp + (size_t)t * FF2), g0); unpack8(*(const u32x4*)(hp + (size_t)t * FF2 + FF), v0);
            float o[8];
#pragma unroll
            for (int j = 0; j < 8; ++j) {
                const float gg = bg[j] + wg[0][j] * g2[j] + wg[1][j] * g1[j] + wg[2][j] * g0[j];
                const float vv = bv[j] + wv[0][j] * v2[j] + wv[1][j] * v1[j] + wv[2][j] * v0[j];
                o[j] = gg * __builtin_amdgcn_rcpf(1.f + __expf(-gg)) * vv;
                g2[j] = g1[j]; g1[j] = g0[j]; v2[j] = v1[j]; v1[j] = v0[j];
            }
            u32x4 w; w.x = cvt_pk_bf16(o[0], o[1]); w.y = cvt_pk_bf16(o[2], o[3]); w.z = cvt_pk_bf16(o[4], o[5]); w.w = cvt_pk_bf16(o[6], o[7]);
            *(u32x4*)(ap + (size_t)t * FF) = w;
        }
    }
}
__device__ __forceinline__ void conv4_phase(const bf16_t* XBR, const float* cw, const float* cb, bf16_t* XBC) {
    const int nitems = NB * 64 * 256;
    for (int item = my_bid() * 512 + my_tid(); item < nitems; item += my_grid() * 512) {
        const int c8 = item & 255, tc = (item >> 8) & 63, b = item >> 14;
        const int c = c8 * 8, t0 = tc * 32;
        float w[4][8], bb[8];
#pragma unroll
        for (int k = 0; k < 4; ++k)
#pragma unroll
            for (int h = 0; h < 2; ++h) { const f32x4 a = *(const f32x4*)(cw + (size_t)k * DM + c + 4 * h);
#pragma unroll
                for (int j = 0; j < 4; ++j) w[k][4 * h + j] = a[j]; }
#pragma unroll
        for (int h = 0; h < 2; ++h) { const f32x4 a = *(const f32x4*)(cb + c + 4 * h);
#pragma unroll
            for (int j = 0; j < 4; ++j) bb[4 * h + j] = a[j]; }
        const bf16_t* xp = XBR + (size_t)b * SEQ * DM + c;
        bf16_t* op = XBC + (size_t)b * SEQ * DM + c;
        float x1[8], x2[8], x3[8];
        if (t0 == 0) {
#pragma unroll
            for (int j = 0; j < 8; ++j) { x1[j] = 0.f; x2[j] = 0.f; x3[j] = 0.f; }
        } else {
            unpack8(*(const u32x4*)(xp + (size_t)(t0 - 1) * DM), x1); unpack8(*(const u32x4*)(xp + (size_t)(t0 - 2) * DM), x2); unpack8(*(const u32x4*)(xp + (size_t)(t0 - 3) * DM), x3);
        }
#pragma unroll 4
        for (int t = t0; t < t0 + 32; ++t) {
            float x0[8]; unpack8(*(const u32x4*)(xp + (size_t)t * DM), x0);
            float o[8];
#pragma unroll
            for (int j = 0; j < 8; ++j) { o[j] = bb[j] + w[0][j] * x3[j] + w[1][j] * x2[j] + w[2][j] * x1[j] + w[3][j] * x0[j]; x3[j] = x2[j]; x2[j] = x1[j]; x1[j] = x0[j]; }
            u32x4 wv; wv.x = cvt_pk_bf16(o[0], o[1]); wv.y = cvt_pk_bf16(o[2], o[3]); wv.z = cvt_pk_bf16(o[4], o[5]); wv.w = cvt_pk_bf16(o[6], o[7]);
            *(u32x4*)(op + (size_t)t * DM) = wv;
        }
    }
}
__device__ __forceinline__ void scan1_phase(const bf16_t* LA, const bf16_t* BTb, float* CP, float* CH) {
    const int nitems = NB * 32 * 512;
    for (int item = my_bid() * 512 + my_tid(); item < nitems; item += my_grid() * 512) {
        const int c4 = item & 511, ck = (item >> 9) & 31, b = item >> 14;
        const size_t base = ((size_t)b * SEQ + ck * 64) * DM + c4 * 4;
        f32x4 L = {0.f, 0.f, 0.f, 0.f}, Hh = {0.f, 0.f, 0.f, 0.f};
#pragma unroll 8
        for (int t = 0; t < 64; ++t) { const u32x2 lw = *(const u32x2*)(LA + base + (size_t)t * DM), bw = *(const u32x2*)(BTb + base + (size_t)t * DM);
            const f32x4 la = {bf_lo(lw.x), bf_hi(lw.x), bf_lo(lw.y), bf_hi(lw.y)}, bt = {bf_lo(bw.x), bf_hi(bw.x), bf_lo(bw.y), bf_hi(bw.y)};
            f32x4 a; a[0] = __expf(la[0]); a[1] = __expf(la[1]); a[2] = __expf(la[2]); a[3] = __expf(la[3]);
            L += la; Hh = a * Hh + bt; }
        const size_t co = ((size_t)b * 32 + ck) * DM + c4 * 4;
        f32x4 P; P[0] = __expf(L[0]); P[1] = __expf(L[1]); P[2] = __expf(L[2]); P[3] = __expf(L[3]);
        *(f32x4*)(CP + co) = P; *(f32x4*)(CH + co) = Hh;
    }
}
__device__ __forceinline__ void scan2_phase(const bf16_t* LA, const bf16_t* BTb, const float* CP, const float* CH, const bf16_t* GATE, bf16_t* YG) {
    const int nitems = NB * 32 * 512;
    for (int item = my_bid() * 512 + my_tid(); item < nitems; item += my_grid() * 512) {
        const int c4 = item & 511, ck = (item >> 9) & 31, b = item >> 14;
        f32x4 Hh = {0.f, 0.f, 0.f, 0.f};
        for (int j = 0; j < ck; ++j) { const size_t co = ((size_t)b * 32 + j) * DM + c4 * 4; Hh = *(const f32x4*)(CP + co) * Hh + *(const f32x4*)(CH + co); }
        const size_t base = ((size_t)b * SEQ + ck * 64) * DM + c4 * 4;
#pragma unroll 8
        for (int t = 0; t < 64; ++t) { const size_t o = base + (size_t)t * DM;
            const u32x2 lw = *(const u32x2*)(LA + o), bw = *(const u32x2*)(BTb + o); const u32x2 gw = *(const u32x2*)(GATE + o);
            const f32x4 bt = {bf_lo(bw.x), bf_hi(bw.x), bf_lo(bw.y), bf_hi(bw.y)};
            f32x4 a; a[0] = __expf(bf_lo(lw.x)); a[1] = __expf(bf_hi(lw.x)); a[2] = __expf(bf_lo(lw.y)); a[3] = __expf(bf_hi(lw.y));
            Hh = a * Hh + bt;
            u32x2 w; w.x = cvt_pk_bf16(Hh[0] * bf_lo(gw.x), Hh[1] * bf_hi(gw.x)); w.y = cvt_pk_bf16(Hh[2] * bf_lo(gw.y), Hh[3] * bf_hi(gw.y));
            *(u32x2*)(YG + o) = w; }
    }
}

#define XB_TMO      128
#define XB_XCNT(j)  (256  + 64 * (j))
#define XB_XSUB(j)  (1280 + 64 * (j))
#define XB_XGEN(j)  (2304 + 64 * (j))
#define XB_TOP      3328
#define XB_TOPGEN   3392
#define XCD_BAR_WORDS 3456
#define XB_SPIN_CAP (1u << 18)
__device__ __forceinline__ unsigned xb_ld(unsigned* p)              { return __hip_atomic_load(p, __ATOMIC_RELAXED, __HIP_MEMORY_SCOPE_AGENT); }
__device__ __forceinline__ unsigned xb_add(unsigned* p, unsigned v) { return __hip_atomic_fetch_add(p, v, __ATOMIC_RELAXED, __HIP_MEMORY_SCOPE_AGENT); }
__device__ __forceinline__ unsigned xb_xcc_id() { return (unsigned)__builtin_amdgcn_s_getreg((3 << 11) | 20) & 0xFu; }
#define XB_SPIN(cond, bar) do { unsigned _sp = 0; while (cond) { __builtin_amdgcn_s_sleep(1); \
    if ((++_sp & 255u) == 0u) { if (xb_ld(&(bar)[XB_TMO])) break; if (_sp > XB_SPIN_CAP) { atomicAdd(&(bar)[XB_TMO], 1u); break; } } } } while (0)
struct XcdBarrier { unsigned* bar; unsigned x; volatile LAS unsigned* st; };
__device__ __forceinline__ XcdBarrier xcd_barrier_post(unsigned* bar, volatile LAS unsigned* st) {
    XcdBarrier b; b.bar = bar; b.x = xb_xcc_id(); b.st = st;
    if (threadIdx.x == 0) (void)xb_add(&bar[XB_XCNT(b.x)], 1u);
    return b;
}
__device__ __forceinline__ void xcd_barrier_complete(unsigned* bar, unsigned x, unsigned& nloc, unsigned& nx) {
    const unsigned G = gridDim.x * gridDim.y * gridDim.z;
    unsigned sum, cnt, mine, sp = 0u;
    for (;;) {
        sum = 0u; cnt = 0u; mine = 0u;
#pragma unroll
        for (unsigned j = 0; j < 16; ++j) { const unsigned c = xb_ld(&bar[XB_XCNT(j)]); sum += c; cnt += (c > 0u) ? 1u : 0u; mine = (j == x) ? c : mine; }
        if (sum == G) break;
        __builtin_amdgcn_s_sleep(1);
        if ((++sp & 255u) == 0u) { if (xb_ld(&bar[XB_TMO])) break; if (sp > XB_SPIN_CAP) { atomicAdd(&bar[XB_TMO], 1u); break; } }
    }
    nloc = mine > 0u ? mine : 1u; nx = cnt > 0u ? cnt : 1u;
}
__device__ __forceinline__ void xcd_barrier(const XcdBarrier& b) {
    asm volatile("s_waitcnt vmcnt(0)" ::: "memory");
    __syncthreads();
    if (threadIdx.x == 0) {
        unsigned* bar = b.bar;
        __builtin_amdgcn_s_waitcnt(0);
        unsigned nloc = b.st[0], nx = b.st[1];
        if (nloc == 0u) { xcd_barrier_complete(bar, b.x, nloc, nx); b.st[0] = nloc; b.st[1] = nx; }
        const unsigned old = xb_add(&bar[XB_XSUB(b.x)], 1u);
        const unsigned gen = old / nloc;
        if (old + 1u == (gen + 1u) * nloc) {
            __builtin_amdgcn_fence(__ATOMIC_RELEASE, "agent");
            asm volatile("s_waitcnt vmcnt(0)" ::: "memory");
            const unsigned og = xb_add(&bar[XB_TOP], 1u);
            const unsigned tg = og / nx;
            if (og + 1u == (tg + 1u) * nx) xb_add(&bar[XB_TOPGEN], 1u);
            else XB_SPIN(xb_ld(&bar[XB_TOPGEN]) == tg, bar);
            __builtin_amdgcn_fence(__ATOMIC_ACQUIRE, "agent");
            xb_add(&bar[XB_XGEN(b.x)], 1u);
            asm volatile("s_waitcnt vmcnt(0)" ::: "memory");
        } else {
            XB_SPIN(xb_ld(&bar[XB_XGEN(b.x)]) == gen, bar);
            __builtin_amdgcn_fence(__ATOMIC_ACQUIRE, "agent");
            asm volatile("s_waitcnt vmcnt(0)" ::: "memory");
        }
    }
    __syncthreads();
}

struct Params { const float* in[21]; float* out; unsigned char* ws; int ph_lo, ph_hi; };

__global__ void __launch_bounds__(512) mega(Params p) {
    extern __shared__ __attribute__((aligned(16))) unsigned char smem[];
    cg::grid_group grid = cg::this_grid();
    LAS unsigned char* lds = (LAS unsigned char*)smem;
    unsigned char* ws = p.ws;
    const int G = gridDim.x;
    const float* x_in = p.in[0];
    bf16_t* W_UP = (bf16_t*)(ws + WS_WUP); bf16_t* W_DN = (bf16_t*)(ws + WS_WDN); bf16_t* W_POOL = (bf16_t*)(ws + WS_WPOOL);
    bf16_t* W_AIN = (bf16_t*)(ws + WS_WAIN); bf16_t* W_AO = (bf16_t*)(ws + WS_WAO); bf16_t* W_RIN = (bf16_t*)(ws + WS_WRIN);
    bf16_t* W_RG = (bf16_t*)(ws + WS_WRG); bf16_t* W_RO = (bf16_t*)(ws + WS_WRO);
    float* XB = (float*)(ws + WS_XB); bf16_t* XBF = (bf16_t*)(ws + WS_XBF);
    bf16_t* Hb = (bf16_t*)(ws + WS_H); bf16_t* ACTb = (bf16_t*)(ws + WS_ACT);
    float* SPb = (float*)(ws + WS_SP); float* STS = (float*)(ws + WS_ST); float* FG = (float*)(ws + WS_FG); float* CP = (float*)(ws + WS_CP); float* CH = (float*)(ws + WS_CH);
    bf16_t* DB = Hb;
    bf16_t* Qb = Hb; bf16_t* Kb = (bf16_t*)(ws + WS_H + TD2); bf16_t* Vb = (bf16_t*)(ws + WS_H + 2 * TD2); bf16_t* Ob = ACTb;
    bf16_t* XBR = Hb; bf16_t* GATE = (bf16_t*)(ws + WS_H + TD2); bf16_t* XBC = (bf16_t*)(ws + WS_H + 2 * TD2); bf16_t* BTb = (bf16_t*)(ws + WS_H + 3 * TD2);
    bf16_t* LA = (bf16_t*)(ws + WS_ACT); bf16_t* YG = Hb;

    volatile LAS unsigned* xst = (volatile LAS unsigned*)(lds + 131072 + 16384 + 32);
    if (threadIdx.x == 0) { xst[0] = 0u; xst[1] = 0u; }
    __syncthreads();
    XcdBarrier xbar; xbar.bar = (unsigned*)(ws + WS_BAR); xbar.x = 0; xbar.st = xst;
    if (!MK_MULTI) xbar = xcd_barrier_post((unsigned*)(ws + WS_BAR), xst);
    int ph = 0; const int lo = p.ph_lo, hi = p.ph_hi;
    if (hi < 0) grid.sync();
#define RUN(...) do { if (ph >= lo && ph < hi) { __VA_ARGS__; if (ph + 1 < hi) xcd_barrier(xbar); } ++ph; } while (0)

    RUN({
        float* tile = (float*)smem;
        for (int l = 0; l < 4; ++l) convT(tile, p.in[17] + (size_t)l * DM * FF2, DM, FF2, FF2, W_UP + (size_t)l * FF2 * DM, l * 64);
        for (int l = 0; l < 4; ++l) convT(tile, p.in[20] + (size_t)l * FF * DM, FF, DM, DM, W_DN + (size_t)l * DM * FF, l * 64 + 32);
        for (int lg = 0; lg < 8; ++lg) convT(tile, p.in[1] + (size_t)lg * 512 * 512, 512, 512, 512, W_POOL + (size_t)lg * 512 * 512, lg * 16);
        convT(tile, p.in[3], DM, 3 * DM + NH, NQKV, W_AIN, 128);
        convT(tile, p.in[5], DM, DM, DM, W_AO, 160);
        convT(tile, p.in[6], DM, 2 * DM, 2 * DM, W_RIN, 192);
        convT(tile, p.in[14], DM, DM, DM, W_RO, 224);
        conv_gates(p.in[9], p.in[11], W_RG);
        for (int i = my_bid() * 512 + my_tid(); i < DM; i += G * 512) SPb[i] = log1pf(__expf(-p.in[13][i]));
        pool_diff(x_in, DB);
    });

    const float* R = x_in;
    int s = 0;
    for (int layer = 0; layer < 4; ++layer) {
        const int kind = layer % 3;
        pg8::Gemm gm;
        const float* cs = nullptr;
        if (kind == 0) {
            const int j = layer / 3;
            if (layer > 0) RUN({ pool_diff(R, DB); });
            gm = pg8::Gemm{DB, W_POOL + (size_t)j * DM * 512, 512, DM, 512, 2, 512}; cs = p.in[2] + (size_t)j * DM;
        } else if (kind == 1) {
            RUN({ pg8::Gemm g{XBF, W_AIN, DM, DM, DM, 1 << 20, 0}; pg8::StaticOrder S; S.init(T, NQKV, G, my_bid());
                  pg8::EpiGen E{Qb, DM, 1, FG}; pg8::gemm_phase<pg8::EpiGen>(lds, g, S, E); });
            RUN({ att::attn_phase((char*)smem, Qb, Kb, Vb, Ob, FG, p.in[4]); });
            gm = pg8::Gemm{Ob, W_AO, DM, DM, DM, 1 << 20, 0};
        } else {
            RUN({ pg8::Gemm g{XBF, W_RIN, DM, DM, DM, 1 << 20, 0}; pg8::StaticOrder S; S.init(T, 2 * DM, G, my_bid());
                  pg8::EpiGen E{XBR, DM, 2, nullptr}; pg8::gemm_phase<pg8::EpiGen>(lds, g, S, E); });
            RUN({ conv4_phase(XBR, p.in[7], p.in[8], XBC); });
            RUN({ pg8::Gemm g{XBC, W_RG, 256, DM, 256, 2, 256}; pg8::StaticOrder S; S.init(T, 4096, G, my_bid());
                  pg8::EpiGates E{p.in[10], p.in[12], SPb, XBC, LA, BTb}; pg8::gemm_phase<pg8::EpiGates>(lds, g, S, E); });
            RUN({ scan1_phase(LA, BTb, CP, CH); });
            RUN({ scan2_phase(LA, BTb, CP, CH, GATE, YG); });
            gm = pg8::Gemm{YG, W_RO, DM, DM, DM, 1 << 20, 0};
        }
        for (int sub = 0; sub < 2; ++sub) {
            if (sub == 1) {
                RUN({ pg8::Gemm g{XBF, W_UP + (size_t)layer * FF2 * DM, DM, DM, DM, 1 << 20, 0}; pg8::StaticOrder S; S.init(T, FF2, G, my_bid());
                      pg8::EpiGen E{Hb, FF2, 0, nullptr}; pg8::gemm_phase<pg8::EpiGen>(lds, g, S, E); });
                RUN({ convgate_phase(Hb, p.in[18] + (size_t)layer * 3 * FF2, p.in[19] + (size_t)layer * FF2, ACTb); });
                gm = pg8::Gemm{ACTb, W_DN + (size_t)layer * DM * FF, FF, FF, FF, 1 << 20, 0}; cs = nullptr;
            }
            float* Y = (s & 1) ? p.out : XB;
            const bool rawR = (s == 0 || s == 6);
            RUN({ pg8::StaticOrder S; S.init(T, DM, G, my_bid());
                  pg8::EpiRes E{R, Y, cs, rawR ? nullptr : STS, p.in[15] + (size_t)(s > 0 ? s - 1 : 0) * DM, p.in[16] + (size_t)(s > 0 ? s - 1 : 0) * DM};
                  pg8::gemm_phase<pg8::EpiRes>(lds, gm, S, E); });
            RUN({ ln_phase(Y, p.in[15] + (size_t)s * DM, p.in[16] + (size_t)s * DM, XBF, STS, s == 5 || s == 7); });
            R = Y; ++s;
        }
    }
#undef RUN
}

constexpr int N_PHASES = 1 + 6 + 8 + 11 + 7;

extern "C" void kernel_launch(void* const* d_in, const int* in_sizes, int n_in, void* d_out, int out_size, void* d_ws, size_t ws_size, hipStream_t stream) {
    static int grid = 0;
    if (grid == 0) {
        if (n_in != 21 || out_size != T * DM || ws_size < WS_END) { fprintf(stderr, "kernel_launch: unexpected shapes (n_in %d out %d ws %zu)\n", n_in, out_size, ws_size); grid = -1; return; }
        int dev = 0, cus = 0, per_cu = 0;
        (void)hipGetDevice(&dev);
        if (hipDeviceGetAttribute(&cus, hipDeviceAttributeMultiprocessorCount, dev) != hipSuccess || cus <= 0) cus = 256;
        if (hipFuncSetAttribute((const void*)mega, hipFuncAttributeMaxDynamicSharedMemorySize, LDS_BYTES) != hipSuccess) { fprintf(stderr, "kernel_launch: hipFuncSetAttribute failed\n"); grid = -1; return; }
        if (hipOccupancyMaxActiveBlocksPerMultiprocessor(&per_cu, (const void*)mega, 512, LDS_BYTES) != hipSuccess || per_cu < 1) { fprintf(stderr, "kernel_launch: occupancy query says %d\n", per_cu); per_cu = 1; }
        (void)hipGetLastError();
        grid = cus;
    }
    if (grid < 0) return;
    Params p{};
    for (int i = 0; i < 21; ++i) p.in[i] = (const float*)d_in[i];
    p.out = (float*)d_out; p.ws = (unsigned char*)d_ws;
#if MK_MULTI
    for (int k = 0; k < N_PHASES; ++k) { p.ph_lo = k; p.ph_hi = k + 1; hipLaunchKernelGGL(mega, dim3(grid), dim3(512), LDS_BYTES, stream, p); }
#else
    p.ph_lo = 0; p.ph_hi = N_PHASES;
    (void)hipMemsetAsync((char*)d_ws + WS_BAR, 0, XCD_BAR_WORDS * 4, stream);
    void* args[] = {&p};
    hipError_t e = hipLaunchCooperativeKernel((const void*)mega, dim3(grid), dim3(512), args, LDS_BYTES, stream);
    if (e != hipSuccess) fprintf(stderr, "kernel_launch: cooperative launch failed: %s (grid %d)\n", hipGetErrorString(e), grid);
#endif
}
```
